# Optimizing an MI355X kernel written in HIP

```python
import math
import jax, jax.numpy as jnp
from jax import lax
import numpy as np

D_MODEL = 1024
BATCH = 1
SEQ = 16384
DEPTH = 2
DEC_BATCH = 16
DEC_SEQ = 16
PAST_LEN = 1024

CHUNK = 64
QBLOCK = 128
MLA_H = 8
NOPE_DIM = 64
ROPE_DIM = 32
MLA_DV = 64
Q_LORA = 384
KV_LORA = 256
MLA_W = MLA_H * MLA_DV
MLA_SCALE = 1.0 / math.sqrt(NOPE_DIM + ROPE_DIM)
ROPE_THETA = 10000.0
FOX_H = 8
FOX_DH = 64
FOX_W = FOX_H * FOX_DH
FOX_SCALE = 1.0 / math.sqrt(FOX_DH)
IN_SIZES = (Q_LORA, KV_LORA, ROPE_DIM, MLA_W, FOX_W, FOX_W, FOX_W, FOX_H, FOX_W, D_MODEL, D_MODEL)
IN_WIDTH = Q_LORA + KV_LORA + ROPE_DIM + MLA_W + 4 * FOX_W + FOX_H + 2 * D_MODEL
EPS = 1e-6
NEG = -1e30

kernel_name = "chunk_causal_mla_fox_hybrid_step"


def rmsnorm(x, g):
    x32 = x.astype(jnp.float32)
    y = x32 * lax.rsqrt(jnp.mean(x32 * x32, axis=-1, keepdims=True) + EPS)
    return (y * g.astype(jnp.float32)).astype(x.dtype)


def rope(x, pos):
    half = x.shape[-1] // 2
    inv = jnp.exp(-math.log(ROPE_THETA) * jnp.arange(half, dtype=jnp.float32) / half)
    ang = pos.astype(jnp.float32)[:, None] * inv[None, :]
    cos = jnp.cos(ang)[:, None, :].astype(x.dtype)
    sin = jnp.sin(ang)[:, None, :].astype(x.dtype)
    x1, x2 = x[..., :half], x[..., half:]
    return jnp.concatenate([x1 * cos - x2 * sin, x1 * sin + x2 * cos], axis=-1)


def project(h, pos, w_in, g_q, w_uq, g_kv, b_f):
    B, T, _ = h.shape
    z = h @ w_in
    offs = np.cumsum(IN_SIZES)[:-1].tolist()
    z_cq, z_ckv, z_kr, za, fq, fk, fv, zf, zb, ga, gb = jnp.split(z, offs, axis=-1)
    cq = rmsnorm(z_cq, g_q)
    q = (cq @ w_uq).reshape(B, T, MLA_H, NOPE_DIM + ROPE_DIM)
    q = jnp.concatenate([q[..., :NOPE_DIM], rope(q[..., NOPE_DIM:], pos)], axis=-1)
    ckv = rmsnorm(z_ckv, g_kv)
    kr = rope(z_kr[:, :, None, :], pos)[:, :, 0, :]
    fq = fq.reshape(B, T, FOX_H, FOX_DH)
    fk = fk.reshape(B, T, FOX_H, FOX_DH)
    fv = fv.reshape(B, T, FOX_H, FOX_DH)
    logf = jax.nn.log_sigmoid((zf + b_f).astype(jnp.float32))
    return q, ckv, kr, za, fq, fk, fv, logf, zb, ga, gb


def mla_expand(ckv, kr, w_ukv):
    B, L, _ = ckv.shape
    kv = (ckv @ w_ukv).reshape(B, L, MLA_H, NOPE_DIM + MLA_DV)
    k = jnp.concatenate([kv[..., :NOPE_DIM], jnp.broadcast_to(kr[:, :, None, :], (B, L, MLA_H, ROPE_DIM))], axis=-1)
    return k, kv[..., NOPE_DIM:]


def attend(q, k, v, qpos, kpos, scale, chunk_causal, cq=None, ck=None):
    s = jnp.einsum('bqhd,bkhd->bhqk', q, k).astype(jnp.float32) * scale
    if cq is not None:
        s = s + (jnp.transpose(cq, (0, 2, 1))[:, :, :, None] - jnp.transpose(ck, (0, 2, 1))[:, :, None, :])
    if chunk_causal:
        ok = (kpos[None, :] // CHUNK) <= (qpos[:, None] // CHUNK)
    else:
        ok = kpos[None, :] <= qpos[:, None]
    s = jnp.where(ok, s, NEG)
    p = jax.nn.softmax(s, axis=-1).astype(v.dtype)
    return jnp.einsum('bhqk,bkhd->bqhd', p, v)


def blocked_attend(q, k, v, pos, scale, chunk_causal, cum=None):
    B, S, H, D = q.shape
    nb = S // QBLOCK
    qb = q.reshape(B, nb, QBLOCK, H, D).swapaxes(0, 1)
    pb = pos.reshape(nb, QBLOCK)
    if cum is None:
        out = lax.map(lambda a: attend(a[0], k, v, a[1], pos, scale, chunk_causal), (qb, pb))
    else:
        cb = cum.reshape(B, nb, QBLOCK, H).swapaxes(0, 1)
        out = lax.map(lambda a: attend(a[0], k, v, a[1], pos, scale, chunk_causal, a[2], cum), (qb, pb, cb))
    return out.swapaxes(0, 1).reshape(B, S, H, v.shape[-1])


def merge(o_a, za, o_b, zb, ga, gb, w_oa, w_ob, w_out):
    B, T = o_a.shape[:2]
    a = (o_a.reshape(B, T, MLA_W) * jax.nn.silu(za)) @ w_oa
    b = (o_b.reshape(B, T, FOX_W) * jax.nn.silu(zb)) @ w_ob
    return (jax.nn.sigmoid(ga) * a + jax.nn.sigmoid(gb) * b) @ w_out


def setup_inputs(seed: int = 0) -> dict:
    key = jax.random.key(seed)
    ks = jax.random.split(key, 24)
    n = lambda k, s, sc: jax.random.normal(k, s, jnp.float32) * sc
    return {
        "x_prompt": n(ks[0], (BATCH, SEQ, D_MODEL), 1.0),
        "x_sample": n(ks[1], (DEC_BATCH, DEC_SEQ, D_MODEL), 1.0),
        "cache_mla_ckv": n(ks[2], (DEPTH, DEC_BATCH, PAST_LEN, KV_LORA), 1.0),
        "cache_mla_krope": n(ks[3], (DEPTH, DEC_BATCH, PAST_LEN, ROPE_DIM), 1.0),
        "cache_fox_k": n(ks[4], (DEPTH, DEC_BATCH, PAST_LEN, FOX_H, FOX_DH), 1.0),
        "cache_fox_v": n(ks[5], (DEPTH, DEC_BATCH, PAST_LEN, FOX_H, FOX_DH), 1.0),
        "cache_fox_logf": jax.nn.log_sigmoid(2.0 + n(ks[6], (DEPTH, DEC_BATCH, PAST_LEN, FOX_H), 0.5)),
        "norm_g": 1.0 + n(ks[7], (DEPTH, D_MODEL), 0.02),
        "w_in": n(ks[8], (DEPTH, D_MODEL, IN_WIDTH), D_MODEL ** -0.5),
        "g_q": 1.0 + n(ks[9], (DEPTH, Q_LORA), 0.02),
        "w_uq": n(ks[10], (DEPTH, Q_LORA, MLA_H * (NOPE_DIM + ROPE_DIM)), Q_LORA ** -0.5),
        "g_kv": 1.0 + n(ks[11], (DEPTH, KV_LORA), 0.02),
        "w_ukv": n(ks[12], (DEPTH, KV_LORA, MLA_H * (NOPE_DIM + MLA_DV)), KV_LORA ** -0.5),
        "b_f": 2.0 + n(ks[13], (DEPTH, FOX_H), 0.5),
        "w_oa": n(ks[14], (DEPTH, MLA_W, D_MODEL), MLA_W ** -0.5),
        "w_ob": n(ks[15], (DEPTH, FOX_W, D_MODEL), FOX_W ** -0.5),
        "w_out": n(ks[16], (DEPTH, D_MODEL, D_MODEL), D_MODEL ** -0.5),
        "final_g": 1.0 + n(ks[17], (D_MODEL,), 0.02),
    }


def reference(x_prompt, x_sample, cache_mla_ckv, cache_mla_krope, cache_fox_k, cache_fox_v, cache_fox_logf,
              norm_g, w_in, g_q, w_uq, g_kv, w_ukv, b_f, w_oa, w_ob, w_out, final_g):
    S = x_prompt.shape[1]
    T = x_sample.shape[1]
    P = cache_mla_ckv.shape[2]
    pos_p = jnp.arange(S, dtype=jnp.int32)
    pos_s = P + jnp.arange(T, dtype=jnp.int32)
    kpos_s = jnp.arange(P + T, dtype=jnp.int32)
    xp, xs = x_prompt, x_sample
    p_ckv, p_kr, p_fk, p_fv, p_lf = [], [], [], [], []
    s_ckv, s_kr, s_fk, s_fv, s_lf = [], [], [], [], []
    for l in range(DEPTH):
        h = rmsnorm(xp, norm_g[l])
        q, ckv, kr, za, fq, fk, fv, logf, zb, ga, gb = project(h, pos_p, w_in[l], g_q[l], w_uq[l], g_kv[l], b_f[l])
        k_a, v_a = mla_expand(ckv, kr, w_ukv[l])
        o_a = blocked_attend(q, k_a, v_a, pos_p, MLA_SCALE, True)
        cum = jnp.cumsum(logf, axis=1)
        o_b = blocked_attend(fq, fk, fv, pos_p, FOX_SCALE, False, cum)
        xp = xp + merge(o_a, za, o_b, zb, ga, gb, w_oa[l], w_ob[l], w_out[l])
        p_ckv.append(ckv); p_kr.append(kr); p_fk.append(fk); p_fv.append(fv); p_lf.append(logf)

        h = rmsnorm(xs, norm_g[l])
        q, ckv, kr, za, fq, fk, fv, logf, zb, ga, gb = project(h, pos_s, w_in[l], g_q[l], w_uq[l], g_kv[l], b_f[l])
        ckv_all = jnp.concatenate([cache_mla_ckv[l].astype(ckv.dtype), ckv], axis=1)
        kr_all = jnp.concatenate([cache_mla_krope[l].astype(kr.dtype), kr], axis=1)
        k_a, v_a = mla_expand(ckv_all, kr_all, w_ukv[l])
        o_a = attend(q, k_a, v_a, pos_s, kpos_s, MLA_SCALE, True)
        fk_all = jnp.concatenate([cache_fox_k[l].astype(fk.dtype), fk], axis=1)
        fv_all = jnp.concatenate([cache_fox_v[l].astype(fv.dtype), fv], axis=1)
        cum = jnp.cumsum(jnp.concatenate([cache_fox_logf[l].astype(jnp.float32), logf], axis=1), axis=1)
        o_b = attend(fq, fk_all, fv_all, pos_s, kpos_s, FOX_SCALE, False, cum[:, P:], cum)
        xs = xs + merge(o_a, za, o_b, zb, ga, gb, w_oa[l], w_ob[l], w_out[l])
        s_ckv.append(ckv); s_kr.append(kr); s_fk.append(fk); s_fv.append(fv); s_lf.append(logf)

    y_prompt = rmsnorm(xp, final_g)
    y_sample = rmsnorm(xs, final_g)
    return (y_prompt, y_sample,
            jnp.stack(p_ckv), jnp.stack(p_kr), jnp.stack(p_fk), jnp.stack(p_fv), jnp.stack(p_lf),
            jnp.stack(s_ckv), jnp.stack(s_kr), jnp.stack(s_fk), jnp.stack(s_fv), jnp.stack(s_lf))
```

```cpp
#include <hip/hip_runtime.h>
#include <hip/hip_cooperative_groups.h>
#include <cstdio>
#include <cstdint>
namespace cg = cooperative_groups;
namespace pg8 {
#define PG8_LAS __attribute__((address_space(3)))
typedef unsigned short bf16_t;
typedef short bf16x8 __attribute__((ext_vector_type(8)));
typedef float f32x4 __attribute__((ext_vector_type(4)));
typedef unsigned u32x4 __attribute__((ext_vector_type(4)));
constexpr int BM = 256, BK = 64, HALF = 128, HTB = HALF * BK * 2  , STAGE_BYTES = 8 * HTB, NXCD = 8, WGM = 8;

__host__ __device__ __forceinline__ int lds_byte(int r, int c) { const int st = (r >> 4) * 2 + (c >> 5), rr = r & 15, cc = c & 31, ob = rr * 64 + cc * 2; return st * 1024 + (ob ^ (((ob >> 9) & 1) << 5)); }
__host__ __device__ __forceinline__ void stage_rc(int b, int& R, int& C) { const int st = b / 1024, sb = b % 1024, swz = sb ^ (((sb >> 9) & 1) << 5); R = (st >> 1) * 16 + swz / 64; C = (st & 1) * 32 + (swz % 64) / 2; }
__host__ __device__ __forceinline__ int perm32(int rho) { const int n = rho >> 4, i = rho & 15; return 8 * (i >> 2) + 4 * n + (i & 3); }

struct Unit { int pm, pn; };
struct Gemm { const bf16_t* A; const bf16_t* Bt; int M, N, K; };

struct StaticOrder {
    int nM, nN, nwg, G, c;
    __host__ __device__ void init(int M, int N, int G_, int c_) { nM = M / BM; nN = N / BM; nwg = nM * nN; G = G_; c = c_; }
    __host__ __device__ bool next(int i, Unit& u) const {
        const long L = (long)i * G + c; if (L >= nwg) return false;
        int wgid = (int)L; { const int q = nwg / NXCD, r = nwg % NXCD, xcd = wgid % NXCD, off = wgid / NXCD; wgid = (xcd < r ? xcd * (q + 1) : r * (q + 1) + (xcd - r) * q) + off; }
        const int nig = WGM * nN, gid = wgid / nig, fm = gid * WGM, gsz = (nM - fm) < WGM ? (nM - fm) : WGM;
        u.pm = fm + ((wgid % nig) % gsz); u.pn = (wgid % nig) / gsz; return true;
    }
    __device__ __forceinline__ void a_ready(const Unit&) const {}
    __device__ __forceinline__ void done(const Unit&) const {}
};

__device__ __forceinline__ unsigned cvt_pk_bf16(float lo, float hi) { unsigned r; asm volatile("v_cvt_pk_bf16_f32 %0, %1, %2" : "=v"(r) : "v"(lo), "v"(hi)); return r; }
typedef float f32x2 __attribute__((ext_vector_type(2)));
template <class Epi, class Sched, bool ALIGN_EPI = false, bool SP2 = false>
__device__ __forceinline__ void gemm_phase(PG8_LAS unsigned char* lds, const Gemm g, const Sched& S, const Epi& E) {
    int tid_ = threadIdx.x; asm volatile("" : "+v"(tid_));
    const int tid = tid_, wid = __builtin_amdgcn_readfirstlane(tid >> 6), lane = tid & 63, wr = wid >> 2, wc = wid & 3, fr = lane & 15, fq = lane >> 4;
    const int K = g.K, nt = K / BK;
    unsigned voffA[2], voffB[2];
#pragma unroll
    for (int i = 0; i < 2; ++i) { int R, C; stage_rc(tid * 16 + i * 8192, R, C); const int Rb = Epi::PERM ? ((R & ~31) + perm32(R & 31)) : R;
        voffA[i] = (unsigned)(R * K + C) * 2u; voffB[i] = (unsigned)(Rb * K + C) * 2u; }
    const size_t kstep = (size_t)(BK * 2);
    const size_t hstep = (size_t)HALF * K * 2;
    const size_t tstep = 2 * hstep;
    const unsigned ldsw = (unsigned)wid * 1024u;
    const int aoff = lds_byte(wr * 64 + fr, fq * 8), boff = lds_byte(wc * 32 + fr, fq * 8);
#define PG8_SA(b, h) (((b) * 2 + (h)) * HTB)
#define PG8_SB(b, h) ((4 + (b) * 2 + (h)) * HTB)
#define PG8_STAGE(bufoff, gbase, voff) do { _Pragma("unroll") for (int _i = 0; _i < 2; ++_i) \
        __builtin_amdgcn_global_load_lds((const unsigned*)((const char*)(gbase) + (voff)[_i]), (PG8_LAS unsigned*)(lds + (bufoff) + ldsw + _i * 8192), 16, 0, 0); } while (0)
#define PG8_LDA(dst, b, h) do { _Pragma("unroll") for (int m = 0; m < 4; ++m) _Pragma("unroll") for (int k = 0; k < 2; ++k) dst[m][k] = *(const PG8_LAS bf16x8*)(lds + PG8_SA(b, h) + aoff + m * 2048 + k * 1024); } while (0)
#define PG8_LDB(dst, b, h) do { _Pragma("unroll") for (int n = 0; n < 2; ++n) _Pragma("unroll") for (int k = 0; k < 2; ++k) dst[n][k] = *(const PG8_LAS bf16x8*)(lds + PG8_SB(b, h) + boff + n * 2048 + k * 1024); } while (0)
#define PG8_MMA(ai, bj, At, Bt) do { __builtin_amdgcn_s_setprio(1); _Pragma("unroll") for (int m = 0; m < 4; ++m) _Pragma("unroll") for (int n = 0; n < 2; ++n) _Pragma("unroll") for (int k = 0; k < 2; ++k) \
        acc[ai][bj][m][n] = __builtin_amdgcn_mfma_f32_16x16x32_bf16(Bt[n][k], At[m][k], acc[ai][bj][m][n], 0, 0, 0); __builtin_amdgcn_s_setprio(0); } while (0)
#define PG8_WAIT_V(n) asm volatile("s_waitcnt vmcnt(" #n ")" ::: "memory")
#define PG8_WAIT_L(n) asm volatile("s_waitcnt lgkmcnt(" #n ")" ::: "memory")
#define PG8_BAR __builtin_amdgcn_s_barrier()
#define PG8_SCHED __builtin_amdgcn_sched_barrier(0)
    Unit cur, nxt; int ui = 0;
    if (!S.next(0, cur)) return;
    f32x4 acc[2][2][4][2];
#pragma unroll
    for (int a = 0; a < 2; ++a)
#pragma unroll
        for (int b = 0; b < 2; ++b)
#pragma unroll
            for (int m = 0; m < 4; ++m)
#pragma unroll
                for (int n = 0; n < 2; ++n) acc[a][b][m][n] = (f32x4){0.f, 0.f, 0.f, 0.f};
    bf16x8 At[4][2], B0[2][2], B1[2][2];
    const char* cA = (const char*)g.A + (size_t)cur.pm * tstep; const char* cB = (const char*)g.Bt + (size_t)cur.pn * tstep;
    S.a_ready(cur);
    if constexpr (SP2) {
        PG8_STAGE(PG8_SB(0, 0), cB, voffB); PG8_STAGE(PG8_SB(0, 1), cB + hstep, voffB); PG8_STAGE(PG8_SA(0, 0), cA, voffA); PG8_STAGE(PG8_SA(0, 1), cA + hstep, voffA);
        if (wr == 1) PG8_BAR;
        PG8_WAIT_V(2); PG8_BAR;
        PG8_STAGE(PG8_SB(1, 0), cB + kstep, voffB); PG8_STAGE(PG8_SA(1, 0), cA + kstep, voffA); PG8_STAGE(PG8_SB(1, 1), cB + hstep + kstep, voffB);
        PG8_WAIT_V(6); PG8_BAR;
    } else {
        PG8_STAGE(PG8_SB(0, 0), cB, voffB); PG8_STAGE(PG8_SA(0, 0), cA, voffA); PG8_STAGE(PG8_SB(0, 1), cB + hstep, voffB); PG8_STAGE(PG8_SA(0, 1), cA + hstep, voffA);
        if (wr == 1) PG8_BAR;
        PG8_WAIT_V(4); PG8_BAR;
        PG8_STAGE(PG8_SB(1, 0), cB + kstep, voffB); PG8_STAGE(PG8_SA(1, 0), cA + kstep, voffA); PG8_STAGE(PG8_SB(1, 1), cB + hstep + kstep, voffB);
        PG8_WAIT_V(6); PG8_BAR;
    }
    for (;;) {
        const bool has_next = S.next(ui + 1, nxt);
        const char* nA = has_next ? (const char*)g.A + (size_t)nxt.pm * tstep : cA; const char* nB = has_next ? (const char*)g.Bt + (size_t)nxt.pn * tstep : cB;
        for (int t = 0; t < nt; t += 2) {
            const bool last = (t == nt - 2);
            const char* a1 = cA + (size_t)(t + 1) * kstep;
            const char* a2 = last ? nA : cA + (size_t)(t + 2) * kstep; const char* b2 = last ? nB : cB + (size_t)(t + 2) * kstep;
            const char* a3 = a2 + kstep; const char* b3 = b2 + kstep;
            if (last && has_next) S.a_ready(nxt);
            if constexpr (SP2) {
            PG8_LDB(B0, 0, 0); PG8_LDB(B1, 0, 1); PG8_SCHED; PG8_LDA(At, 0, 0); PG8_STAGE(PG8_SA(1, 1), a1 + hstep, voffA);
            PG8_WAIT_V(8); PG8_WAIT_L(0); PG8_BAR; PG8_MMA(0, 0, At, B0); PG8_MMA(0, 1, At, B1); PG8_BAR; PG8_SCHED;
            PG8_LDA(At, 0, 1); PG8_STAGE(PG8_SB(0, 0), b2, voffB); PG8_STAGE(PG8_SB(0, 1), b2 + hstep, voffB); PG8_STAGE(PG8_SA(0, 0), a2, voffA);
            PG8_WAIT_V(8); PG8_WAIT_L(0); PG8_BAR; PG8_MMA(1, 0, At, B0); PG8_MMA(1, 1, At, B1); PG8_BAR; PG8_SCHED;
            PG8_LDB(B0, 1, 0); PG8_LDB(B1, 1, 1); PG8_SCHED; PG8_LDA(At, 1, 0); PG8_STAGE(PG8_SA(0, 1), a2 + hstep, voffA);
            PG8_WAIT_V(8); PG8_WAIT_L(0); PG8_BAR; PG8_MMA(0, 0, At, B0); PG8_MMA(0, 1, At, B1); PG8_BAR; PG8_SCHED;
            PG8_LDA(At, 1, 1); PG8_STAGE(PG8_SB(1, 0), b3, voffB); PG8_STAGE(PG8_SB(1, 1), b3 + hstep, voffB); PG8_STAGE(PG8_SA(1, 0), a3, voffA);
            PG8_WAIT_V(8); PG8_WAIT_L(0); PG8_BAR; PG8_MMA(1, 0, At, B0); PG8_MMA(1, 1, At, B1); PG8_BAR; PG8_SCHED;
            } else {
            PG8_LDB(B0, 0, 0); PG8_SCHED; PG8_LDA(At, 0, 0); PG8_STAGE(PG8_SA(1, 1), a1 + hstep, voffA);
            PG8_WAIT_L(8); PG8_BAR; PG8_WAIT_L(0); PG8_MMA(0, 0, At, B0); PG8_BAR; PG8_SCHED;
            PG8_LDB(B1, 0, 1); PG8_STAGE(PG8_SB(0, 0), b2, voffB);
            PG8_BAR; PG8_WAIT_L(0); PG8_MMA(0, 1, At, B1); PG8_BAR;
            PG8_LDA(At, 0, 1); PG8_STAGE(PG8_SA(0, 0), a2, voffA);
            PG8_BAR; PG8_WAIT_L(0); PG8_MMA(1, 0, At, B0); PG8_BAR; PG8_SCHED;
            PG8_STAGE(PG8_SB(0, 1), b2 + hstep, voffB);
            PG8_WAIT_V(6); PG8_BAR; PG8_MMA(1, 1, At, B1); PG8_BAR;
            PG8_LDB(B0, 1, 0); PG8_SCHED; PG8_LDA(At, 1, 0); PG8_STAGE(PG8_SA(0, 1), a2 + hstep, voffA);
            PG8_WAIT_L(8); PG8_BAR; PG8_WAIT_L(0); PG8_MMA(0, 0, At, B0); PG8_BAR; PG8_SCHED;
            PG8_LDB(B1, 1, 1); PG8_STAGE(PG8_SB(1, 0), b3, voffB);
            PG8_BAR; PG8_WAIT_L(0); PG8_MMA(0, 1, At, B1); PG8_BAR;
            PG8_LDA(At, 1, 1); PG8_STAGE(PG8_SA(1, 0), a3, voffA);
            PG8_BAR; PG8_WAIT_L(0); PG8_MMA(1, 0, At, B0); PG8_BAR; PG8_SCHED;
            PG8_STAGE(PG8_SB(1, 1), b3 + hstep, voffB);
            PG8_WAIT_V(6); PG8_BAR; PG8_MMA(1, 1, At, B1); PG8_BAR;
            }
        }
        if constexpr (ALIGN_EPI) { if (wr == 0) PG8_BAR; }
        if constexpr (!Epi::AFTER_DRAIN) { E(acc, cur, wr, wc, fr, fq); S.done(cur); }
        if (!has_next) break;
#pragma unroll
        for (int a = 0; a < 2; ++a)
#pragma unroll
            for (int b = 0; b < 2; ++b)
#pragma unroll
                for (int m = 0; m < 4; ++m)
#pragma unroll
                    for (int n = 0; n < 2; ++n) acc[a][b][m][n] = (f32x4){0.f, 0.f, 0.f, 0.f};
        cur = nxt; cA = nA; cB = nB; ++ui;
        if constexpr (ALIGN_EPI) { if (wr == 1) PG8_BAR; }
    }
    PG8_WAIT_V(0);
    if constexpr (!ALIGN_EPI) { if (wr == 0) PG8_BAR; }
    PG8_BAR;
    if constexpr (Epi::AFTER_DRAIN) { E.fused(acc, cur, wr, wc, fr, fq, lds, wid, lane); S.done(cur); }
#undef PG8_SA
#undef PG8_SB
#undef PG8_STAGE
#undef PG8_LDA
#undef PG8_LDB
#undef PG8_MMA
#undef PG8_WAIT_V
#undef PG8_WAIT_L
#undef PG8_BAR
#undef PG8_SCHED
}
}

#ifndef MK_MULTI
#define MK_MULTI 0
#endif
#define LAS __attribute__((address_space(3)))
using pg8::bf16_t; using pg8::bf16x8; using pg8::f32x4; using pg8::u32x4; using pg8::Unit;
typedef float f32x16 __attribute__((ext_vector_type(16)));
typedef float f32x2v __attribute__((ext_vector_type(2)));
typedef unsigned u32x2 __attribute__((ext_vector_type(2)));

constexpr int MP = 16384, MSM = 256, MT = MP + MSM;
constexpr int DM = 1024, NIN = 5376, NINSRC = 5288;
constexpr int PAST = 1024, TKEYS = 1040;
constexpr float LOG2E = 1.4426950408889634f;
constexpr float C2F = 0.125f * LOG2E;
constexpr float C2M = 0.10206207261596577f * LOG2E;
constexpr float EPSN = 1e-6f;
constexpr float NEGB = -1e30f;

constexpr size_t MiB = 1u << 20;
constexpr size_t WS_W = 0;
constexpr size_t W_IN = 0, W_UQ = 11 * MiB, W_UK = 11 * MiB + 768 * 1024, W_UV = 12 * MiB, W_OA = 12 * MiB + 512 * 1024, W_OB = 13 * MiB + 512 * 1024, W_OUT = 14 * MiB + 512 * 1024;
constexpr size_t WS_A1 = 17 * MiB;
constexpr size_t WS_A2 = 50 * MiB;
constexpr size_t WS_SA = 83 * MiB, WS_SB = 99 * MiB + 512 * 1024;
constexpr size_t WS_GA = 116 * MiB, WS_GB = 149 * MiB;
constexpr size_t WS_VTF = 182 * MiB;
constexpr size_t WS_MISC = 198 * MiB + 512 * 1024;
constexpr size_t MI_KR = 0, MI_TAB = MiB + 256 * 1024, MI_LOGF = 3 * MiB + 256 * 1024, MI_CUM2 = 4 * MiB, MI_CUMS = 4 * MiB + 512 * 1024, MI_KMAX = 5 * MiB + 256 * 1024, MI_BAR = 5 * MiB + 320 * 1024, MI_RSQ = 5 * MiB + 336 * 1024, MI_RSK = MI_RSQ + 66560;
constexpr size_t WS_A8 = 204 * MiB;
constexpr size_t A8_QF = 0, A8_KF = 16 * MiB + 256 * 1024, A8_KN = 32 * MiB + 512 * 1024, A8_VTM = 48 * MiB + 512 * 1024;
constexpr size_t WS_CQ = 269 * MiB;
constexpr size_t WS_END = 282 * MiB;

constexpr size_t O_Y = 0, O_PCKV = 17039360, O_PKR = 25427968, O_PFK = 26476544, O_PFV = 43253760, O_PLF = 60030976,
                 O_SCKV = 60293120, O_SKR = 60424192, O_SFK = 60440576, O_SFV = 60702720, O_SLF = 60964864, O_TOTAL = 60968960;

constexpr int LDS_BYTES = 132096;

struct Params { const float* in[18]; float* out; unsigned char* ws; int ph_lo, ph_hi; };

__device__ __forceinline__ float bf2f(unsigned short u) { return __uint_as_float((unsigned)u << 16); }
__device__ __forceinline__ unsigned f2bf(float f) { unsigned u = __builtin_bit_cast(unsigned, f); return (u + 0x7fffu + ((u >> 16) & 1u)) >> 16; }
__device__ __forceinline__ unsigned pk2(float lo, float hi) { return f2bf(lo) | (f2bf(hi) << 16); }
__device__ __forceinline__ float wave_sum(float v) {
#pragma unroll
    for (int o = 1; o < 64; o <<= 1) v += __shfl_xor(v, o);
    return v;
}
__device__ __forceinline__ float wave_max(float v) {
#pragma unroll
    for (int o = 1; o < 64; o <<= 1) v = fmaxf(v, __shfl_xor(v, o));
    return v;
}
__device__ __forceinline__ float sigmoidf_(float x) { return __builtin_amdgcn_rcpf(1.0f + __builtin_amdgcn_exp2f(x * -1.4426950408889634f)); }


__device__ __forceinline__ const float* ldptr(LAS unsigned char* lds, int k) {
    const LAS unsigned* t = (const LAS unsigned*)(lds + 131072) + 2 * k; const unsigned lo = __builtin_amdgcn_readfirstlane(t[0]), hi = __builtin_amdgcn_readfirstlane(t[1]);
    return (const float*)(const __attribute__((address_space(1))) float*)(((unsigned long long)hi << 32) | (unsigned long long)lo);
}
#define PIN_(k) ldptr(lds, (k))
#define POUT_ ((float*)ldptr(lds, 18))
#define PWS_ ((unsigned char*)ldptr(lds, 19))
#define EPI_FOREACH(...) \
    _Pragma("unroll") for (int ai = 0; ai < 2; ++ai) _Pragma("unroll") for (int m = 0; m < 4; ++m) { \
        int rt = ai * 128 + wr * 64 + m * 16 + fr; asm volatile("" : "+v"(rt)); const int row = u.pm * 256 + rt; (void)row; \
        _Pragma("unroll") for (int bj = 0; bj < 2; ++bj) { f32x4 v0 = acc[ai][bj][m][0], v1 = acc[ai][bj][m][1]; int ct = bj * 128 + wc * 32 + fq * 8; asm volatile("" : "+v"(ct)); __VA_ARGS__ } asm volatile("" ::: "memory"); }

__device__ __forceinline__ void st8f(float* p, f32x4 a, f32x4 b) { *(f32x4*)p = a; *(f32x4*)(p + 4) = b; }
__device__ __forceinline__ void st8b(bf16_t* p, f32x4 a, f32x4 b) { u32x4 w; w.x = pg8::cvt_pk_bf16(a[0], a[1]); w.y = pg8::cvt_pk_bf16(a[2], a[3]); w.z = pg8::cvt_pk_bf16(b[0], b[1]); w.w = pg8::cvt_pk_bf16(b[2], b[3]); *(u32x4*)p = w; }
__device__ __forceinline__ void ld8b(const bf16_t* p, f32x4& a, f32x4& b) { const u32x4 w = *(const u32x4*)p;
    a[0] = __uint_as_float(w.x << 16); a[1] = __uint_as_float(w.x & 0xffff0000u); a[2] = __uint_as_float(w.y << 16); a[3] = __uint_as_float(w.y & 0xffff0000u);
    b[0] = __uint_as_float(w.z << 16); b[1] = __uint_as_float(w.z & 0xffff0000u); b[2] = __uint_as_float(w.w << 16); b[3] = __uint_as_float(w.w & 0xffff0000u); }

__device__ __forceinline__ void rope8(f32x4& v0, f32x4& v1, const float* tabrow, int fq) {
    const int i0 = (fq & 1) * 8;
    const f32x4 c0 = *(const f32x4*)(tabrow + i0), c1 = *(const f32x4*)(tabrow + i0 + 4), s0 = *(const f32x4*)(tabrow + 16 + i0), s1 = *(const f32x4*)(tabrow + 16 + i0 + 4);
    f32x4 p0, p1;
#pragma unroll
    for (int j = 0; j < 4; ++j) { p0[j] = __shfl_xor(v0[j], 32); p1[j] = __shfl_xor(v1[j], 32); }
    if (fq < 2) { v0 = v0 * c0 - p0 * s0; v1 = v1 * c1 - p1 * s1; }
    else        { v0 = p0 * s0 + v0 * c0; v1 = p1 * s1 + v1 * c1; }
}

#define CQ_PART(col_) do { const int c_ = (col_); float ss_ = (v0[0] * v0[0] + v0[1] * v0[1]) + (v0[2] * v0[2] + v0[3] * v0[3]) + (v1[0] * v1[0] + v1[1] * v1[1]) + (v1[2] * v1[2] + v1[3] * v1[3]); \
        ss_ += __shfl_xor(ss_, 16); ss_ += __shfl_xor(ss_, 32); if (fq == 0) atomicAdd(RSQ + row, ss_); \
        const f32x4 g0_ = *(const f32x4*)(gq + c_), g1_ = *(const f32x4*)(gq + c_ + 4); st8b(CQ + (size_t)row * 384 + c_, v0 * g0_, v1 * g1_); } while (0)
struct EpiIn {
    static constexpr bool PERM = true, AFTER_DRAIN = false;
    bf16_t *CQ, *CKV; float *RSQ, *RSK; const float *gq, *gkv; bf16_t *SA, *SB, *Qf, *Kf, *GA, *GB, *KR; float* LOGF; const float* TAB; const float* bfv; float* out; int layer;
    __device__ __forceinline__ void operator()(const f32x4 (&acc)[2][2][4][2], const Unit& u, int wr, int wc, int fr, int fq) const {
        const int pn = u.pn; const bool samp = (u.pm == 64); const int L = layer;
        if (pn == 0) { EPI_FOREACH( CQ_PART(ct); ) }
        else if (pn == 1) {
            EPI_FOREACH(
                if (bj == 0) { CQ_PART(256 + ct); }
                else if (wc == 0) {
                    const int pos = samp ? (PAST + (rt & 15)) : row;
                    rope8(v0, v1, TAB + (size_t)pos * 32, fq);
                    float* o = samp ? (out + O_SKR + (size_t)L * MSM * 32 + (size_t)rt * 32) : (out + O_PKR + (size_t)L * MP * 32 + (size_t)row * 32);
                    st8f(o + fq * 8, v0, v1); st8b(KR + (size_t)row * 32 + fq * 8, v0, v1);
                } else if (wc == 1 && fq == 0) {
                    float lf[8];
                    _Pragma("unroll")
                    for (int j = 0; j < 8; ++j) { const float x = (j < 4 ? v0[j] : v1[j - 4]) + bfv[j]; lf[j] = fminf(x, 0.f) - log1pf(expf(-fabsf(x))); }
                    float* o = samp ? (out + O_SLF + (size_t)L * MSM * 8 + (size_t)rt * 8) : (out + O_PLF + (size_t)L * MP * 8 + (size_t)row * 8);
                    const f32x4 a = {lf[0], lf[1], lf[2], lf[3]}, b = {lf[4], lf[5], lf[6], lf[7]};
                    st8f(o, a, b); st8f(LOGF + (size_t)row * 8, a, b);
                }
            )
        }
        else if (pn == 2) { float* o = samp ? (out + O_SCKV + (size_t)L * MSM * 256) : (out + O_PCKV + (size_t)L * MP * 256);
            EPI_FOREACH( st8f(o + (size_t)(samp ? rt : row) * 256 + ct, v0, v1);
                { float ss_ = (v0[0] * v0[0] + v0[1] * v0[1]) + (v0[2] * v0[2] + v0[3] * v0[3]) + (v1[0] * v1[0] + v1[1] * v1[1]) + (v1[2] * v1[2] + v1[3] * v1[3]); ss_ += __shfl_xor(ss_, 16); ss_ += __shfl_xor(ss_, 32);
                  if (fq == 0) atomicAdd(RSK + row, ss_);
                  const f32x4 g0_ = *(const f32x4*)(gkv + ct), g1_ = *(const f32x4*)(gkv + ct + 4); st8b(CKV + (size_t)row * 256 + ct, v0 * g0_, v1 * g1_); } ) }
        else if (pn < 7) { bf16_t* o = (pn < 5) ? SA : SB; const int cb = ((pn - 3) & 1) * 256;
            EPI_FOREACH(
                _Pragma("unroll")
                for (int j = 0; j < 4; ++j) { v0[j] = v0[j] * sigmoidf_(v0[j]); v1[j] = v1[j] * sigmoidf_(v1[j]); }
                st8b(o + (size_t)row * 512 + cb + ct, v0, v1); ) }
        else if (pn < 9) { const int cb = (pn - 7) * 256;
            EPI_FOREACH( v0 = v0 * C2F; v1 = v1 * C2F; st8b(Qf + (size_t)row * 512 + cb + ct, v0, v1); ) }
        else if (pn < 11) { const int cb = (pn - 9) * 256; float* o = samp ? (out + O_SFK + (size_t)L * MSM * 512) : (out + O_PFK + (size_t)L * MP * 512);
            EPI_FOREACH( st8f(o + (size_t)(samp ? rt : row) * 512 + cb + ct, v0, v1); st8b(Kf + (size_t)row * 512 + cb + ct, v0, v1); ) }
        else if (pn < 13) { const int cb = (pn - 11) * 256; float* o = samp ? (out + O_SFV + (size_t)L * MSM * 512) : (out + O_PFV + (size_t)L * MP * 512);
            EPI_FOREACH( st8f(o + (size_t)(samp ? rt : row) * 512 + cb + ct, v0, v1); ) }
        else { bf16_t* o = (pn < 17) ? GA : GB; const int cb = ((pn - 13) & 3) * 256;
            EPI_FOREACH(
                _Pragma("unroll")
                for (int j = 0; j < 4; ++j) { v0[j] = sigmoidf_(v0[j]); v1[j] = sigmoidf_(v1[j]); }
                st8b(o + (size_t)row * 1024 + cb + ct, v0, v1); ) }
    }
};
struct EpiPlain {
    static constexpr bool PERM = true, AFTER_DRAIN = false;
    bf16_t* O; int ldc; const float* RS; int mode;
    __device__ __forceinline__ void operator()(const f32x4 (&acc)[2][2][4][2], const Unit& u, int wr, int wc, int fr, int fq) const {
        if (mode == 0) { EPI_FOREACH( st8b(O + (size_t)row * ldc + u.pn * 256 + ct, v0, v1); ) }
        else if (mode == 1) { EPI_FOREACH( const float sc_ = __builtin_amdgcn_rsqf(RS[row] * (1.f / 256.f) + EPSN); st8b(O + (size_t)row * ldc + u.pn * 256 + ct, v0 * sc_, v1 * sc_); ) }
        else { EPI_FOREACH( const int c_ = u.pn * 256 + ct; f32x4 r0_ = *(const f32x4*)(RS + c_), r1_ = *(const f32x4*)(RS + c_ + 4);
                _Pragma("unroll") for (int j = 0; j < 4; ++j) { v0[j] *= __builtin_amdgcn_rsqf(r0_[j] * (1.f / 256.f) + EPSN); v1[j] *= __builtin_amdgcn_rsqf(r1_[j] * (1.f / 256.f) + EPSN); }
                st8b(O + (size_t)row * ldc + c_, v0, v1); ) }
    }
};
struct EpiQ {
    static constexpr bool PERM = true, AFTER_DRAIN = false;
    bf16_t* Qm; const float* TAB; const float* RSQ;
    __device__ __forceinline__ void operator()(const f32x4 (&acc)[2][2][4][2], const Unit& u, int wr, int wc, int fr, int fq) const {
        const bool samp = (u.pm == 64);
        if (u.pn < 2) { EPI_FOREACH( const float sc_ = C2M * __builtin_amdgcn_rsqf(RSQ[row] * (1.f / 384.f) + EPSN); v0 = v0 * sc_; v1 = v1 * sc_; st8b(Qm + (size_t)row * 768 + u.pn * 256 + ct, v0, v1); ) }
        else { EPI_FOREACH( const int pos = samp ? (PAST + (rt & 15)) : row; rope8(v0, v1, TAB + (size_t)pos * 32, fq); const float sc_ = C2M * __builtin_amdgcn_rsqf(RSQ[row] * (1.f / 384.f) + EPSN); v0 = v0 * sc_; v1 = v1 * sc_; st8b(Qm + (size_t)row * 768 + 512 + ct, v0, v1); ) }
    }
};
__device__ __forceinline__ void unpk8(const u32x4 w, f32x4& a, f32x4& b) {
    a[0] = __uint_as_float(w.x << 16); a[1] = __uint_as_float(w.x & 0xffff0000u); a[2] = __uint_as_float(w.y << 16); a[3] = __uint_as_float(w.y & 0xffff0000u);
    b[0] = __uint_as_float(w.z << 16); b[1] = __uint_as_float(w.z & 0xffff0000u); b[2] = __uint_as_float(w.w << 16); b[3] = __uint_as_float(w.w & 0xffff0000u); }
#define EPI_ROWOFF(gi_, off_) size_t off_; { int rt_ = ((gi_) >> 2) * 128 + wr * 64 + ((gi_) & 3) * 16 + fr; asm volatile("" : "+v"(rt_)); off_ = (size_t)(u.pm * 256 + rt_) * 1024 + u.pn * 256 + wc * 32 + fq * 8; }
struct EpiGateA {
    static constexpr bool PERM = true, AFTER_DRAIN = false;
    const bf16_t* G; bf16_t* U;
    __device__ __forceinline__ void operator()(const f32x4 (&acc)[2][2][4][2], const Unit& u, int wr, int wc, int fr, int fq) const {
        u32x4 cur[2], nxt[2];
        { EPI_ROWOFF(0, o0_) cur[0] = *(const u32x4*)(G + o0_); cur[1] = *(const u32x4*)(G + o0_ + 128); }
#pragma unroll
        for (int gi = 0; gi < 8; ++gi) {
            if (gi < 7) { EPI_ROWOFF(gi + 1, on_) nxt[0] = *(const u32x4*)(G + on_); nxt[1] = *(const u32x4*)(G + on_ + 128); }
            EPI_ROWOFF(gi, o_)
#pragma unroll
            for (int bj = 0; bj < 2; ++bj) { f32x4 g0, g1; unpk8(cur[bj], g0, g1); st8b(U + o_ + bj * 128, acc[gi >> 2][bj][gi & 3][0] * g0, acc[gi >> 2][bj][gi & 3][1] * g1); }
            asm volatile("" ::: "memory");
            cur[0] = nxt[0]; cur[1] = nxt[1];
        }
    }
};
struct EpiGateB {
    static constexpr bool PERM = true, AFTER_DRAIN = false;
    const bf16_t* G; bf16_t* U;
    __device__ __forceinline__ void operator()(const f32x4 (&acc)[2][2][4][2], const Unit& u, int wr, int wc, int fr, int fq) const {
        u32x4 cg[2], cu[2], ng[2], nu[2];
        { EPI_ROWOFF(0, o0_) cg[0] = *(const u32x4*)(G + o0_); cg[1] = *(const u32x4*)(G + o0_ + 128); cu[0] = *(const u32x4*)(U + o0_); cu[1] = *(const u32x4*)(U + o0_ + 128); }
#pragma unroll
        for (int gi = 0; gi < 8; ++gi) {
            if (gi < 7) { EPI_ROWOFF(gi + 1, on_) ng[0] = *(const u32x4*)(G + on_); ng[1] = *(const u32x4*)(G + on_ + 128); nu[0] = *(const u32x4*)(U + on_); nu[1] = *(const u32x4*)(U + on_ + 128); }
            EPI_ROWOFF(gi, o_)
#pragma unroll
            for (int bj = 0; bj < 2; ++bj) { f32x4 g0, g1, a0, a1; unpk8(cg[bj], g0, g1); unpk8(cu[bj], a0, a1);
                st8b(U + o_ + bj * 128, a0 + acc[gi >> 2][bj][gi & 3][0] * g0, a1 + acc[gi >> 2][bj][gi & 3][1] * g1); }
            asm volatile("" ::: "memory");
            cg[0] = ng[0]; cg[1] = ng[1]; cu[0] = nu[0]; cu[1] = nu[1];
        }
    }
};
struct EpiOut {
    static constexpr bool PERM = true, AFTER_DRAIN = false;
    const float* xp; const float* xs; float* y; int layer;
    __device__ __forceinline__ void operator()(const f32x4 (&acc)[2][2][4][2], const Unit& u, int wr, int wc, int fr, int fq) const {
        const float* rb = (layer == 0) ? xp : (const float*)y;
        f32x4 cur[2][2], nxt[2][2];
        { EPI_ROWOFF(0, o0_) cur[0][0] = *(const f32x4*)(rb + o0_); cur[0][1] = *(const f32x4*)(rb + o0_ + 4); cur[1][0] = *(const f32x4*)(rb + o0_ + 128); cur[1][1] = *(const f32x4*)(rb + o0_ + 132); }
#pragma unroll
        for (int gi = 0; gi < 8; ++gi) {
            if (gi < 7) { EPI_ROWOFF(gi + 1, on_) nxt[0][0] = *(const f32x4*)(rb + on_); nxt[0][1] = *(const f32x4*)(rb + on_ + 4); nxt[1][0] = *(const f32x4*)(rb + on_ + 128); nxt[1][1] = *(const f32x4*)(rb + on_ + 132); }
            EPI_ROWOFF(gi, o_)
#pragma unroll
            for (int bj = 0; bj < 2; ++bj) st8f(y + o_ + bj * 128, cur[bj][0] + acc[gi >> 2][bj][gi & 3][0], cur[bj][1] + acc[gi >> 2][bj][gi & 3][1]);
            asm volatile("" ::: "memory");
#pragma unroll
            for (int bj = 0; bj < 2; ++bj) { cur[bj][0] = nxt[bj][0]; cur[bj][1] = nxt[bj][1]; }
        }
    }
};

__device__ __forceinline__ int src_col(int mode, int n) {
    if (mode == 0) {
        if (n < 384) return n;
        if (n < 416) return 640 + (n - 384);
        if (n < 424) return 2720 + (n - 416);
        if (n < 512) return -1;
        if (n < 768) return 384 + (n - 512);
        if (n < 1280) return 672 + (n - 768);
        if (n < 1792) return 2728 + (n - 1280);
        if (n < 2304) return 1184 + (n - 1792);
        if (n < 2816) return 1696 + (n - 2304);
        if (n < 3328) return 2208 + (n - 2816);
        if (n < 4352) return 3240 + (n - 3328);
        return 4264 + (n - 4352);
    }
    if (mode == 1) { if (n < 512) return (n >> 6) * 96 + (n & 63); const int m = n - 512; return (m >> 5) * 96 + 64 + (m & 31); }
    if (mode == 2) return (n >> 6) * 128 + (n & 63);
    if (mode == 3) return (n >> 6) * 128 + 64 + (n & 63);
    return n;
}
__device__ __forceinline__ void tr_item(const float* W, int K, int Nsrc, int nblk, bf16_t* WT, int mode, LAS float* scr, int item, int lane) {
    const int kb = item / nblk, nb = item % nblk, k0 = 64 * kb, n0 = 32 * nb;
    const int sc = src_col(mode, n0 + (lane & 31));
#pragma unroll 32
    for (int i = 0; i < 32; ++i) { const int kk = 2 * i + (lane >> 5); scr[kk * 33 + (lane & 31)] = (sc >= 0) ? W[(size_t)(k0 + kk) * Nsrc + sc] : 0.f; }
    asm volatile("s_waitcnt lgkmcnt(0)" ::: "memory");
    const int c = lane & 7;
#pragma unroll
    for (int j = 0; j < 4; ++j) { const int n = (lane >> 3) + 8 * j; const LAS float* s = scr + (8 * c) * 33 + n;
        u32x4 o; o.x = pk2(s[0 * 33], s[1 * 33]); o.y = pk2(s[2 * 33], s[3 * 33]); o.z = pk2(s[4 * 33], s[5 * 33]); o.w = pk2(s[6 * 33], s[7 * 33]);
        *(u32x4*)(WT + (size_t)(n0 + n) * K + k0 + 8 * c) = o; }
    asm volatile("s_waitcnt lgkmcnt(0)" ::: "memory");
}
__device__ __forceinline__ void convert_weights(int l, LAS unsigned char* lds, int gw, int NGW, int wave, int lane) {
    LAS float* scr = (LAS float*)(lds + wave * 16384);
    unsigned char* wb = PWS_ + WS_W;
    const float* w_in = PIN_(8) + (size_t)l * DM * NINSRC; const float* w_uq = PIN_(10) + (size_t)l * 384 * 768; const float* w_ukv = PIN_(12) + (size_t)l * 256 * 1024;
    const float* w_oa = PIN_(14) + (size_t)l * 512 * 1024; const float* w_ob = PIN_(15) + (size_t)l * 512 * 1024; const float* w_out = PIN_(16) + (size_t)l * 1024 * 1024;
    constexpr int I_IN = 16 * (NIN / 32), I_UQ = 6 * 24, I_UK = 4 * 16, I_OA = 8 * 32, I_OUT = 16 * 32;
    constexpr int NITEMS = I_IN + I_UQ + 2 * I_UK + 2 * I_OA + I_OUT;
    for (int it = gw; it < NITEMS; it += NGW) {
        int r = it;
        if (r < I_IN) { tr_item(w_in, 1024, NINSRC, NIN / 32, (bf16_t*)(wb + W_IN), 0, scr, r, lane); continue; } r -= I_IN;
        if (r < I_UQ) { tr_item(w_uq, 384, 768, 24, (bf16_t*)(wb + W_UQ), 1, scr, r, lane); continue; } r -= I_UQ;
        if (r < I_UK) { tr_item(w_ukv, 256, 1024, 16, (bf16_t*)(wb + W_UK), 2, scr, r, lane); continue; } r -= I_UK;
        if (r < I_UK) { tr_item(w_ukv, 256, 1024, 16, (bf16_t*)(wb + W_UV), 3, scr, r, lane); continue; } r -= I_UK;
        if (r < I_OA) { tr_item(w_oa, 512, 1024, 32, (bf16_t*)(wb + W_OA), 4, scr, r, lane); continue; } r -= I_OA;
        if (r < I_OA) { tr_item(w_ob, 512, 1024, 32, (bf16_t*)(wb + W_OB), 4, scr, r, lane); continue; } r -= I_OA;
        tr_item(w_out, 1024, 1024, 32, (bf16_t*)(wb + W_OUT), 4, scr, r, lane);
    }
}
__device__ __forceinline__ void rms_row_1024(const float* xrow, const float* g, bf16_t* hout, float* fout, int lane) {
    const f32x4* xr = (const f32x4*)xrow + lane; const f32x4* gr = (const f32x4*)g + lane;
    f32x4 v[4]; float s = 0.f;
#pragma unroll
    for (int j = 0; j < 4; ++j) { v[j] = xr[64 * j]; s += (v[j].x * v[j].x + v[j].y * v[j].y) + (v[j].z * v[j].z + v[j].w * v[j].w); }
    const float inv = 1.0f / sqrtf(wave_sum(s) * (1.f / 1024.f) + EPSN);
#pragma unroll
    for (int j = 0; j < 4; ++j) { const f32x4 o = v[j] * inv * gr[64 * j];
        if (hout) { u32x2 w; w.x = pk2(o.x, o.y); w.y = pk2(o.z, o.w); *((u32x2*)hout + lane + 64 * j) = w; }
        else *((f32x4*)fout + lane + 64 * j) = o; }
}

__device__ __forceinline__ void rms_rows2_1024(const float* x1, const float* x2, const float* g, bf16_t* h1, bf16_t* h2, int lane) {
    const f32x4* a = (const f32x4*)x1 + lane; const f32x4* b = (const f32x4*)(x2 ? x2 : x1) + lane; const f32x4* gr = (const f32x4*)g + lane;
    f32x4 v[4], u[4]; float s1 = 0.f, s2 = 0.f;
#pragma unroll
    for (int j = 0; j < 4; ++j) { v[j] = a[64 * j]; u[j] = b[64 * j]; }
#pragma unroll
    for (int j = 0; j < 4; ++j) { s1 += (v[j].x * v[j].x + v[j].y * v[j].y) + (v[j].z * v[j].z + v[j].w * v[j].w); s2 += (u[j].x * u[j].x + u[j].y * u[j].y) + (u[j].z * u[j].z + u[j].w * u[j].w); }
#pragma unroll
    for (int o = 1; o < 64; o <<= 1) { s1 += __shfl_xor(s1, o); s2 += __shfl_xor(s2, o); }
    const float i1 = 1.0f / sqrtf(s1 * (1.f / 1024.f) + EPSN), i2 = 1.0f / sqrtf(s2 * (1.f / 1024.f) + EPSN);
#pragma unroll
    for (int j = 0; j < 4; ++j) { const f32x4 gg = gr[64 * j]; const f32x4 o1 = v[j] * i1 * gg, o2 = u[j] * i2 * gg;
        u32x2 w1; w1.x = pk2(o1.x, o1.y); w1.y = pk2(o1.z, o1.w); *((u32x2*)h1 + lane + 64 * j) = w1;
        if (h2) { u32x2 w2; w2.x = pk2(o2.x, o2.y); w2.y = pk2(o2.z, o2.w); *((u32x2*)h2 + lane + 64 * j) = w2; } }
}

__device__ __forceinline__ void rms_rows2_f32(float* x1, float* x2, const float* g, int lane) {
    f32x4* a = (f32x4*)x1 + lane; f32x4* b = (f32x4*)(x2 ? x2 : x1) + lane; const f32x4* gr = (const f32x4*)g + lane;
    f32x4 v[4], u[4]; float s1 = 0.f, s2 = 0.f;
#pragma unroll
    for (int j = 0; j < 4; ++j) { v[j] = a[64 * j]; u[j] = b[64 * j]; }
#pragma unroll
    for (int j = 0; j < 4; ++j) { s1 += (v[j].x * v[j].x + v[j].y * v[j].y) + (v[j].z * v[j].z + v[j].w * v[j].w); s2 += (u[j].x * u[j].x + u[j].y * u[j].y) + (u[j].z * u[j].z + u[j].w * u[j].w); }
#pragma unroll
    for (int o = 1; o < 64; o <<= 1) { s1 += __shfl_xor(s1, o); s2 += __shfl_xor(s2, o); }
    const float i1 = 1.0f / sqrtf(s1 * (1.f / 1024.f) + EPSN), i2 = 1.0f / sqrtf(s2 * (1.f / 1024.f) + EPSN);
#pragma unroll
    for (int j = 0; j < 4; ++j) { const f32x4 gg = gr[64 * j]; a[64 * j] = v[j] * i1 * gg; if (x2) b[64 * j] = u[j] * i2 * gg; }
}

__device__ __forceinline__ int crow(int r, int hi) { return (r & 3) + 8 * (r >> 2) + 4 * hi; }
struct AttnP { const bf16_t* Q; const bf16_t* K; const bf16_t* KR; const bf16_t* Vt; int vtp; const float* cum2; bf16_t* GO; const float* kmax; const bf16_t* GI; };
template <int DQK, bool FOX>
__device__ __forceinline__ void attn_unit_prompt(const AttnP& a, int h, int qb, LAS unsigned char* lds, int tid) {
    constexpr int ND = DQK / 16, KP = DQK * 2 + 16, VP = 144, KBYTES = 64 * KP, VBYTES = 64 * VP, BUF = KBYTES + VBYTES + 256;
    asm volatile("" : "+v"(tid));
    const int lane = tid & 63, r32 = lane & 31, hi = lane >> 5, w = __builtin_amdgcn_readfirstlane(tid >> 6);
    const int q = qb * 256 + w * 32 + r32;
    bf16x8 qr[ND];
    if (FOX) {
#pragma unroll
        for (int d0 = 0; d0 < ND; ++d0) qr[d0] = *(const bf16x8*)(a.Q + (size_t)q * 512 + h * 64 + d0 * 16 + hi * 8);
    } else {
#pragma unroll
        for (int d0 = 0; d0 < ND; ++d0) qr[d0] = (d0 < 4) ? *(const bf16x8*)(a.Q + (size_t)q * 768 + h * 64 + d0 * 16 + hi * 8)
                                                          : *(const bf16x8*)(a.Q + (size_t)q * 768 + 512 + h * 32 + (d0 - 4) * 16 + hi * 8);
    }
    float cq2 = 0.f; if (FOX) cq2 = a.cum2[(size_t)h * MP + q];
    const int NT = 4 * qb + 4, tmax = 4 * qb + (w >> 1);
    const int srow = tid >> 3, sch = tid & 7;
    const bf16_t* kg = a.K + (size_t)srow * 512 + h * 64 + sch * 8;
    const bf16_t* vg = a.Vt + (size_t)(h * 64 + srow) * a.vtp + sch * 8;
    const bf16_t* krg = FOX ? nullptr : a.KR + (size_t)(tid >> 2) * 32 + (tid & 3) * 8;
    const float* cg_ = FOX ? a.cum2 + (size_t)h * MP + (tid & 15) * 4 : nullptr;
    const unsigned kw = srow * KP + sch * 16, krw = (tid >> 2) * KP + 128 + (tid & 3) * 16;
    const unsigned vw0 = KBYTES + srow * VP + ((sch >> 1) * 16 + (sch & 1) * 4) * 2, vw1 = vw0 + 16;
    const unsigned cw = KBYTES + VBYTES + (tid & 15) * 16;
    u32x4 gk, gv, gkr = {0u, 0u, 0u, 0u}; f32x4 gc = {0.f, 0.f, 0.f, 0.f};
    { const int t0 = FOX ? NT - 1 : 0;
      gk = *(const u32x4*)(kg + (size_t)t0 * 64 * 512); gv = *(const u32x4*)(vg + t0 * 64);
      if (!FOX) { if (tid < 256) gkr = *(const u32x4*)(krg + (size_t)t0 * 64 * 32); } else { if (tid < 16) gc = *(const f32x4*)(cg_ + t0 * 64); } }
    float mrow = NEGB, lsum = 0.f; f32x16 o0 = {}, o1 = {};
    const unsigned kr0 = (unsigned)r32 * KP + hi * 16, vr0 = KBYTES + (unsigned)r32 * VP + hi * 16;
    float qkb = 0.f;
    if (FOX) { float ss = 0.f;
#pragma unroll
        for (int d0 = 0; d0 < ND; ++d0)
#pragma unroll
            for (int e = 0; e < 8; ++e) { const float v = bf2f((unsigned short)qr[d0][e]); ss += v * v; }
        ss += __shfl_xor(ss, 32);
        const f32x4 km = *(const f32x4*)(a.kmax + h * 256 + lane * 4);
        qkb = sqrtf(ss) * 1.002f * wave_max(fmaxf(fmaxf(km.x, km.y), fmaxf(km.z, km.w))) + cq2; }
    int done = 0;
    LAS int* flg = (LAS int*)(lds + 131072 + 512);
    for (int i = 0; i < NT; ++i) {
        const int t = FOX ? NT - 1 - i : i;
        LAS unsigned char* B = lds + (i & 1) * BUF;
        *(LAS u32x4*)(B + kw) = gk;
        *(LAS u32x2*)(B + vw0) = (u32x2){gv.x, gv.y}; *(LAS u32x2*)(B + vw1) = (u32x2){gv.z, gv.w};
        if (!FOX) { if (tid < 256) *(LAS u32x4*)(B + krw) = gkr; } else { if (tid < 16) *(LAS f32x4*)(B + cw) = gc; if (lane == 0) flg[(i & 1) * 8 + w] = done; }
        __syncthreads();
        if (FOX) { const LAS int* f = flg + (i & 1) * 8; if (f[0] & f[1] & f[2] & f[3] & f[4] & f[5] & f[6] & f[7]) break; }
        if (i + 1 < NT) { const int tn = FOX ? t - 1 : t + 1;
            gk = *(const u32x4*)(kg + (size_t)tn * 64 * 512); gv = *(const u32x4*)(vg + tn * 64);
            if (!FOX) { if (tid < 256) gkr = *(const u32x4*)(krg + (size_t)tn * 64 * 32); } else { if (tid < 16) gc = *(const f32x4*)(cg_ + tn * 64); }
        }
        if (t <= tmax && !done) {
            f32x16 p0, p1;
            if (FOX) {
#pragma unroll
                for (int g = 0; g < 4; ++g) { const f32x4 c0 = *(const LAS f32x4*)(B + KBYTES + VBYTES + (2 * g + hi) * 16), c1 = *(const LAS f32x4*)(B + KBYTES + VBYTES + 128 + (2 * g + hi) * 16);
#pragma unroll
                    for (int j = 0; j < 4; ++j) { p0[4 * g + j] = c0[j]; p1[4 * g + j] = c1[j]; } }
            } else { p0 = f32x16{}; p1 = f32x16{}; }
            bf16x8 kf[2 * ND], vf[8];
#pragma unroll
            for (int d0 = 0; d0 < ND; ++d0) { kf[2 * d0] = *(const LAS bf16x8*)(B + kr0 + d0 * 32); kf[2 * d0 + 1] = *(const LAS bf16x8*)(B + kr0 + 32 * KP + d0 * 32); }
            __builtin_amdgcn_sched_barrier(0);
            if (FOX) { p0 = cq2 - p0; p1 = cq2 - p1; }
            __builtin_amdgcn_s_setprio(1);
#pragma unroll
            for (int d0 = 0; d0 < ND; ++d0) {
                p0 = __builtin_amdgcn_mfma_f32_32x32x16_bf16(kf[2 * d0], qr[d0], p0, 0, 0, 0);
                p1 = __builtin_amdgcn_mfma_f32_32x32x16_bf16(kf[2 * d0 + 1], qr[d0], p1, 0, 0, 0);
            }
            __builtin_amdgcn_s_setprio(0);
#pragma unroll
            for (int s = 0; s < 4; ++s) { vf[2 * s] = *(const LAS bf16x8*)(B + vr0 + s * 32); vf[2 * s + 1] = *(const LAS bf16x8*)(B + vr0 + 32 * VP + s * 32); }
            __builtin_amdgcn_sched_barrier(0);
            if (FOX && t == tmax) { const int ql = q - 64 * t;
#pragma unroll
                for (int r = 0; r < 16; ++r) { const int kv = crow(r, hi); if (kv > ql) p0[r] = NEGB; if (kv + 32 > ql) p1[r] = NEGB; } }
            float mx = fmaxf(p0[0], p1[0]);
#pragma unroll
            for (int r = 1; r < 16; ++r) mx = fmaxf(mx, fmaxf(p0[r], p1[r]));
            mx = fmaxf(mx, __shfl_xor(mx, 32));
            const float mnew = fmaxf(mrow, mx);
            if (__any(mnew > mrow)) { const float alpha = __builtin_amdgcn_exp2f(mrow - mnew); mrow = mnew; lsum *= alpha; o0 = o0 * alpha; o1 = o1 * alpha; }
            p0 = p0 - mrow; p1 = p1 - mrow;
#pragma unroll
            for (int r = 0; r < 16; ++r) { p0[r] = __builtin_amdgcn_exp2f(p0[r]); p1[r] = __builtin_amdgcn_exp2f(p1[r]); }
            { const f32x16 ps = p0 + p1; lsum += ((ps[0] + ps[1]) + (ps[2] + ps[3])) + ((ps[4] + ps[5]) + (ps[6] + ps[7])) + (((ps[8] + ps[9]) + (ps[10] + ps[11])) + ((ps[12] + ps[13]) + (ps[14] + ps[15]))); }
            u32x4 pw[4];
#pragma unroll
            for (int s = 0; s < 2; ++s) {
                pw[s].x = pg8::cvt_pk_bf16(p0[8 * s + 0], p0[8 * s + 1]); pw[s].y = pg8::cvt_pk_bf16(p0[8 * s + 2], p0[8 * s + 3]); pw[s].z = pg8::cvt_pk_bf16(p0[8 * s + 4], p0[8 * s + 5]); pw[s].w = pg8::cvt_pk_bf16(p0[8 * s + 6], p0[8 * s + 7]);
                pw[2 + s].x = pg8::cvt_pk_bf16(p1[8 * s + 0], p1[8 * s + 1]); pw[2 + s].y = pg8::cvt_pk_bf16(p1[8 * s + 2], p1[8 * s + 3]); pw[2 + s].z = pg8::cvt_pk_bf16(p1[8 * s + 4], p1[8 * s + 5]); pw[2 + s].w = pg8::cvt_pk_bf16(p1[8 * s + 6], p1[8 * s + 7]);
            }
            __builtin_amdgcn_s_setprio(1);
#pragma unroll
            for (int s = 0; s < 4; ++s) {
                const bf16x8 pb = __builtin_bit_cast(bf16x8, pw[s]);
                o0 = __builtin_amdgcn_mfma_f32_32x32x16_bf16(vf[2 * s], pb, o0, 0, 0, 0);
                o1 = __builtin_amdgcn_mfma_f32_32x32x16_bf16(vf[2 * s + 1], pb, o1, 0, 0, 0);
            }
            __builtin_amdgcn_s_setprio(0);
            if (FOX && t > 0) { const float c2l = a.cum2[(size_t)h * MP + 64 * t - 1]; done = __all(qkb - c2l < mrow - 160.f) ? 1 : 0; }
        }
    }
    lsum += __shfl_xor(lsum, 32);
    const float inv = 1.0f / lsum;
    bf16_t* go = a.GO + (size_t)q * 512 + h * 64;
    const bf16_t* gi = a.GI + (size_t)q * 512 + h * 64;
#pragma unroll
    for (int db = 0; db < 2; ++db)
#pragma unroll
        for (int m = 0; m < 2; ++m) {
            const f32x16& o = db ? o1 : o0;
            f32x4 xa, xb;
#pragma unroll
            for (int jj = 0; jj < 4; ++jj) {
                const auto rr = __builtin_amdgcn_permlane32_swap(__float_as_uint(o[8 * m + jj] * inv), __float_as_uint(o[8 * m + 4 + jj] * inv), false, false);
                xa[jj] = __uint_as_float(rr[0]); xb[jj] = __uint_as_float(rr[1]); }
            const int dd = db * 32 + 16 * m + 8 * hi;
            f32x4 g0, g1; ld8b(gi + dd, g0, g1); st8b(go + dd, xa * g0, xb * g1);
        }
}

__device__ __forceinline__ void softmax_rows16(LAS float* S, int wave, int lane) {
#pragma unroll 1
    for (int rr = 0; rr < 2; ++rr) { LAS float* s = S + (2 * wave + rr) * TKEYS;
        float mx = NEGB; for (int j = lane; j < TKEYS; j += 64) mx = fmaxf(mx, s[j]);
        mx = wave_max(mx);
        float sum = 0.f; for (int j = lane; j < TKEYS; j += 64) { const float e = __builtin_amdgcn_exp2f(s[j] - mx); s[j] = e; sum += e; }
        sum = wave_sum(sum); const float inv = 1.0f / sum;
        for (int j = lane; j < TKEYS; j += 64) s[j] *= inv; }
}
__device__ __forceinline__ bf16x8 cvt8(const f32x4 a, const f32x4 b) { u32x4 w; w.x = pg8::cvt_pk_bf16(a[0], a[1]); w.y = pg8::cvt_pk_bf16(a[2], a[3]); w.z = pg8::cvt_pk_bf16(b[0], b[1]); w.w = pg8::cvt_pk_bf16(b[2], b[3]); return __builtin_bit_cast(bf16x8, w); }
__device__ __forceinline__ bf16x8 pfrag(const LAS float* S, int ks, int r32, int hi) { const LAS float* p = S + (r32 & 15) * TKEYS + ks * 16 + hi * 8; return cvt8(*(const LAS f32x4*)p, *(const LAS f32x4*)(p + 4)); }

__device__ __forceinline__ void sample_fox_unit(int l, int b, int h, LAS unsigned char* lds, int tid, bool dummy = false) {
    LAS float* S = (LAS float*)(lds + 4096); LAS float* Op = (LAS float*)(lds + 4096 + 66560);
    const int wave = __builtin_amdgcn_readfirstlane(tid >> 6), lane = tid & 63, r32 = lane & 31, hi = lane >> 5;
    const bf16_t* Qf = (const bf16_t*)(PWS_ + WS_A8 + A8_QF); bf16_t* GO = (bf16_t*)(PWS_ + WS_SB);
    const float* cum = (const float*)(PWS_ + WS_MISC + MI_CUMS) + (size_t)(b * 8 + h) * TKEYS;
    const float* ck = PIN_(4) + (size_t)l * 16 * PAST * 512 + (size_t)b * PAST * 512 + h * 64; const float* cv = PIN_(5) + (size_t)l * 16 * PAST * 512 + (size_t)b * PAST * 512 + h * 64;
    const float* nk = POUT_ + O_SFK + (size_t)l * MSM * 512 + (size_t)b * 16 * 512 + h * 64; const float* nv = POUT_ + O_SFV + (size_t)l * MSM * 512 + (size_t)b * 16 * 512 + h * 64;
    { bf16x8 qf[4];
#pragma unroll
      for (int d0 = 0; d0 < 4; ++d0) qf[d0] = *(const bf16x8*)(Qf + (size_t)(MP + b * 16 + (r32 & 15)) * 512 + h * 64 + d0 * 16 + hi * 8);
      const float cqv = cum[PAST + (r32 & 15)];
      for (int kb = wave; kb < 33; kb += 8) {
          const int j = kb * 32 + r32, jj = j < TKEYS ? j : TKEYS - 1; const float* kr = (jj < PAST) ? ck + (size_t)jj * 512 : nk + (size_t)(jj - PAST) * 512;
          f32x16 p = {};
#pragma unroll
          for (int d0 = 0; d0 < 4; ++d0) { const f32x4 a0 = *(const f32x4*)(kr + d0 * 16 + hi * 8), a1 = *(const f32x4*)(kr + d0 * 16 + hi * 8 + 4); p = __builtin_amdgcn_mfma_f32_32x32x16_bf16(cvt8(a0, a1), qf[d0], p, 0, 0, 0); }
          if (r32 < 16) {
#pragma unroll
              for (int g = 0; g < 4; ++g) { const int key = kb * 32 + 8 * g + 4 * hi; if (key < TKEYS) { const f32x4 cj = *(const f32x4*)(cum + key); f32x4 v;
#pragma unroll
                  for (int e = 0; e < 4; ++e) { v[e] = p[4 * g + e] + (cqv - cj[e]) * LOG2E; if (key + e > PAST + r32) v[e] = NEGB; }
                  *(LAS f32x4*)(S + r32 * TKEYS + key) = v; } }
          }
      } }
    __syncthreads();
    softmax_rows16(S, wave, lane);
    __syncthreads();
    { const int nb = wave & 1; f32x16 o = {};
#pragma unroll 9
      for (int ks = wave >> 1; ks < 65; ks += 4) { const float* vr = (ks < 64) ? cv + (size_t)(ks * 16 + hi * 8) * 512 : nv + (size_t)(hi * 8) * 512; f32x4 a0, a1;
#pragma unroll
          for (int e = 0; e < 4; ++e) { a0[e] = vr[(size_t)e * 512 + nb * 32 + r32]; a1[e] = vr[(size_t)(e + 4) * 512 + nb * 32 + r32]; }
          o = __builtin_amdgcn_mfma_f32_32x32x16_bf16(cvt8(a0, a1), pfrag(S, ks, r32, hi), o, 0, 0, 0); }
      if (r32 < 16) {
#pragma unroll
          for (int g = 0; g < 4; ++g) *(LAS f32x4*)(Op + ((wave >> 1) * 16 + r32) * 64 + nb * 32 + 8 * g + 4 * hi) = (f32x4){o[4 * g], o[4 * g + 1], o[4 * g + 2], o[4 * g + 3]};
      } }
    __syncthreads();
    for (int e = tid; e < 1024; e += 512) { const int t = e >> 6, d = e & 63; const float o = (Op[(0 * 16 + t) * 64 + d] + Op[(1 * 16 + t) * 64 + d]) + (Op[(2 * 16 + t) * 64 + d] + Op[(3 * 16 + t) * 64 + d]);
        bf16_t* g0 = GO + (size_t)(MP + b * 16 + t) * 512 + h * 64 + d; bf16_t* d0_ = dummy ? (bf16_t*)(PWS_ + WS_A1) + (g0 - GO) : g0; *d0_ = (bf16_t)f2bf(o * bf2f(*g0)); }
    __syncthreads();
}
__device__ __forceinline__ void sample_mla_unit(int l, int b, int h, LAS unsigned char* lds, int tid, bool dummy = false) {
    LAS float* Qn = (LAS float*)lds; LAS float* Qx = (LAS float*)(lds + 4096); LAS float* S = (LAS float*)(lds + 22528); LAS float* Ol = (LAS float*)(lds + 89088);
    const int wave = __builtin_amdgcn_readfirstlane(tid >> 6), lane = tid & 63, r32 = lane & 31, hi = lane >> 5;
    const bf16_t* Qm = (const bf16_t*)(PWS_ + WS_A2); bf16_t* GO = (bf16_t*)(PWS_ + WS_SA);
    const float* w_ukv = PIN_(12) + (size_t)l * 256 * 1024;
    const float* cc = PIN_(2) + (size_t)l * 16 * PAST * 256 + (size_t)b * PAST * 256; const float* ckr = PIN_(3) + (size_t)l * 16 * PAST * 32 + (size_t)b * PAST * 32;
    const float* nc = POUT_ + O_SCKV + (size_t)l * MSM * 256 + (size_t)b * 16 * 256; const float* nkr = POUT_ + O_SKR + (size_t)l * MSM * 32 + (size_t)b * 16 * 32;
    for (int e = tid; e < 1024; e += 512) { const int t = e >> 6, d = e & 63; Qn[e] = bf2f(Qm[(size_t)(MP + b * 16 + t) * 768 + h * 64 + d]); }
    { const int t = tid >> 5, i = tid & 31; Qx[t * 288 + 256 + i] = bf2f(Qm[(size_t)(MP + b * 16 + t) * 768 + 512 + h * 32 + i]); }
    __syncthreads();
    { const int c = tid & 255, tg = tid >> 8; const float* wr_ = w_ukv + (size_t)c * 1024 + h * 128; float acc8[8];
#pragma unroll
      for (int tt = 0; tt < 8; ++tt) acc8[tt] = 0.f;
#pragma unroll 16
      for (int d4 = 0; d4 < 16; ++d4) { const f32x4 w4 = *(const f32x4*)(wr_ + d4 * 4);
#pragma unroll
          for (int tt = 0; tt < 8; ++tt) { const f32x4 q4 = *(const LAS f32x4*)(Qn + (8 * tg + tt) * 64 + d4 * 4); acc8[tt] += (w4.x * q4.x + w4.y * q4.y) + (w4.z * q4.z + w4.w * q4.w); } }
#pragma unroll
      for (int tt = 0; tt < 8; ++tt) Qx[(8 * tg + tt) * 288 + c] = acc8[tt]; }
    __syncthreads();
    { bf16x8 qf[18];
#pragma unroll
      for (int d0 = 0; d0 < 18; ++d0) { const LAS float* p = Qx + (r32 & 15) * 288 + d0 * 16 + hi * 8; qf[d0] = cvt8(*(const LAS f32x4*)p, *(const LAS f32x4*)(p + 4)); }
      for (int kb = wave; kb < 33; kb += 8) {
          const int j = kb * 32 + r32, jj = j < TKEYS ? j : TKEYS - 1;
          const float* kc = (jj < PAST) ? cc + (size_t)jj * 256 : nc + (size_t)(jj - PAST) * 256; const float* kk = (jj < PAST) ? ckr + (size_t)jj * 32 : nkr + (size_t)(jj - PAST) * 32;
          f32x16 p = {};
#pragma unroll
          for (int d0 = 0; d0 < 18; ++d0) { const float* src = (d0 < 16) ? kc + d0 * 16 + hi * 8 : kk + (d0 - 16) * 16 + hi * 8;
              const f32x4 a0 = *(const f32x4*)src, a1 = *(const f32x4*)(src + 4); p = __builtin_amdgcn_mfma_f32_32x32x16_bf16(cvt8(a0, a1), qf[d0], p, 0, 0, 0); }
          if (r32 < 16) {
#pragma unroll
              for (int g = 0; g < 4; ++g) { const int key = kb * 32 + 8 * g + 4 * hi; if (key < TKEYS) *(LAS f32x4*)(S + r32 * TKEYS + key) = (f32x4){p[4 * g], p[4 * g + 1], p[4 * g + 2], p[4 * g + 3]}; }
          }
      } }
    __syncthreads();
    softmax_rows16(S, wave, lane);
    __syncthreads();
    { f32x16 o = {};
#pragma unroll 13
      for (int ks = 0; ks < 65; ++ks) { const float* vr = (ks < 64) ? cc + (size_t)(ks * 16 + hi * 8) * 256 : nc + (size_t)(hi * 8) * 256; f32x4 a0, a1;
#pragma unroll
          for (int e = 0; e < 4; ++e) { a0[e] = vr[(size_t)e * 256 + wave * 32 + r32]; a1[e] = vr[(size_t)(e + 4) * 256 + wave * 32 + r32]; }
          o = __builtin_amdgcn_mfma_f32_32x32x16_bf16(cvt8(a0, a1), pfrag(S, ks, r32, hi), o, 0, 0, 0); }
      if (r32 < 16) {
#pragma unroll
          for (int g = 0; g < 4; ++g) *(LAS f32x4*)(Ol + r32 * 256 + wave * 32 + 8 * g + 4 * hi) = (f32x4){o[4 * g], o[4 * g + 1], o[4 * g + 2], o[4 * g + 3]};
      } }
    __syncthreads();
    { const int d = tid & 63, cgp = tid >> 6; const float* wv = w_ukv + h * 128 + 64 + d + (size_t)(cgp * 32) * 1024; float acc[16];
#pragma unroll
      for (int t = 0; t < 16; ++t) acc[t] = 0.f;
#pragma unroll 8
      for (int c = 0; c < 32; ++c) { const float wv_ = wv[(size_t)c * 1024];
#pragma unroll
          for (int t = 0; t < 16; ++t) acc[t] += Ol[t * 256 + cgp * 32 + c] * wv_; }
#pragma unroll
      for (int t = 0; t < 16; ++t) S[(cgp * 16 + t) * 64 + d] = acc[t]; }
    __syncthreads();
    for (int e = tid; e < 1024; e += 512) { const int t = e >> 6, d = e & 63; float o = 0.f;
#pragma unroll
        for (int g = 0; g < 8; ++g) o += S[(g * 16 + t) * 64 + d];
        bf16_t* g0 = GO + (size_t)(MP + b * 16 + t) * 512 + h * 64 + d; bf16_t* d0_ = dummy ? (bf16_t*)(PWS_ + WS_A1) + (g0 - GO) : g0; *d0_ = (bf16_t)f2bf(o * bf2f(*g0)); }
    __syncthreads();
}

template <int NK>
__device__ __forceinline__ f32x16 mini_acc(const bf16_t* A, int lda, const bf16_t* Bt, int ldb, int wave, int r32, int hi) {
    const bf16_t* ap = A + (size_t)r32 * lda + hi * 8; const bf16_t* bp = Bt + (size_t)r32 * ldb + hi * 8;
    bf16x8 af[NK], bfr[NK];
#pragma unroll
    for (int s_ = 0; s_ < NK; ++s_) { const int ks = wave + 8 * s_; af[s_] = *(const bf16x8*)(ap + ks * 16); bfr[s_] = *(const bf16x8*)(bp + ks * 16); }
    f32x16 acc = {};
#pragma unroll
    for (int s_ = 0; s_ < NK; ++s_) acc = __builtin_amdgcn_mfma_f32_32x32x16_bf16(af[s_], bfr[s_], acc, 0, 0, 0);
    return acc;
}
__device__ __forceinline__ void mini_put(LAS float* Pp, const f32x16& acc, int wave, int r32, int hi) {
#pragma unroll
    for (int r = 0; r < 16; ++r) Pp[(wave * 32 + crow(r, hi)) * 32 + r32] = acc[r];
}
__device__ __forceinline__ float mini_sum(const LAS float* Pp, int i_, int j_) { float v = 0.f;
#pragma unroll
    for (int w2 = 0; w2 < 8; ++w2) v += Pp[(w2 * 32 + i_) * 32 + j_];
    return v; }

template <class Epi>
__device__ __forceinline__ void run_gemm(LAS unsigned char* lds, const bf16_t* A, const bf16_t* Bt, int M, int N, int K, int rot, const Epi& E) {
    int G = gridDim.x, bx = blockIdx.x, Kv = K; asm volatile("" : "+s"(Kv), "+s"(G), "+s"(bx));
    pg8::Gemm g{A, Bt, M, N, Kv}; pg8::StaticOrder S; S.init(M, N, G, (int)((bx + G - (rot % G)) % G));
    pg8::gemm_phase<Epi, pg8::StaticOrder, true, true>(lds, g, S, E);
}

typedef unsigned v4u_unused_;
#define XB_TMO      128
#define XB_XCNT(j)  (256  + 64 * (j))
#define XB_XSUB(j)  (1280 + 64 * (j))
#define XB_XGEN(j)  (2304 + 64 * (j))
#define XB_TOP      3328
#define XB_TOPGEN   3392
#define XCD_BAR_WORDS 3456
#define XB_SPIN_CAP (1u << 18)

__device__ __forceinline__ unsigned xb_ld(unsigned* p)              { return __hip_atomic_load(p, __ATOMIC_RELAXED, __HIP_MEMORY_SCOPE_AGENT); }
__device__ __forceinline__ unsigned xb_add(unsigned* p, unsigned v) { return __hip_atomic_fetch_add(p, v, __ATOMIC_RELAXED, __HIP_MEMORY_SCOPE_AGENT); }
__device__ __forceinline__ unsigned xb_xcc_id() { return (unsigned)__builtin_amdgcn_s_getreg((3 << 11) | 20) & 0xFu; }
#define XB_SPIN(cond, bar) do { unsigned _sp = 0; while (cond) { __builtin_amdgcn_s_sleep(1); \
    if ((++_sp & 255u) == 0u) { if (xb_ld(&(bar)[XB_TMO])) break; if (_sp > XB_SPIN_CAP) { atomicAdd(&(bar)[XB_TMO], 1u); break; } } } } while (0)

struct XcdBarrier {
    unsigned* bar; unsigned x;
    volatile LAS unsigned* st;
};

__device__ __forceinline__ XcdBarrier xcd_barrier_post(unsigned* bar, volatile LAS unsigned* st) {
    XcdBarrier b; b.bar = bar; b.x = xb_xcc_id(); b.st = st;
    if (threadIdx.x == 0) (void)xb_add(&bar[XB_XCNT(b.x)], 1u);
    return b;
}
__device__ __forceinline__ void xcd_barrier_complete(unsigned* bar, unsigned x, unsigned& nloc, unsigned& nx) {
    const unsigned G = gridDim.x * gridDim.y * gridDim.z;
    unsigned sum, cnt, mine, sp = 0u;
    for (;;) {
        sum = 0u; cnt = 0u; mine = 0u;
#pragma unroll
        for (unsigned j = 0; j < 16; ++j) { const unsigned c = xb_ld(&bar[XB_XCNT(j)]); sum += c; cnt += (c > 0u) ? 1u : 0u; mine = (j == x) ? c : mine; }
        if (sum == G) break;
        __builtin_amdgcn_s_sleep(1);
        if ((++sp & 255u) == 0u) { if (xb_ld(&bar[XB_TMO])) break; if (sp > XB_SPIN_CAP) { atomicAdd(&bar[XB_TMO], 1u); break; } }
    }
    nloc = mine > 0u ? mine : 1u; nx = cnt > 0u ? cnt : 1u;
}

__device__ __forceinline__ void xcd_barrier(const XcdBarrier& b) {
    asm volatile("s_waitcnt vmcnt(0)" ::: "memory");
    __syncthreads();
    if (threadIdx.x == 0) {
        unsigned* bar = b.bar;
        __builtin_amdgcn_s_waitcnt(0);
        unsigned nloc = b.st[0], nx = b.st[1];
        if (nloc == 0u) { xcd_barrier_complete(bar, b.x, nloc, nx); b.st[0] = nloc; b.st[1] = nx; }
        const unsigned old = xb_add(&bar[XB_XSUB(b.x)], 1u);
        const unsigned gen = old / nloc;
        if (old + 1u == (gen + 1u) * nloc) {
            __builtin_amdgcn_fence(__ATOMIC_RELEASE, "agent");
            asm volatile("s_waitcnt vmcnt(0)" ::: "memory");
            const unsigned og = xb_add(&bar[XB_TOP], 1u);
            const unsigned tg = og / nx;
            if (og + 1u == (tg + 1u) * nx) xb_add(&bar[XB_TOPGEN], 1u);
            else XB_SPIN(xb_ld(&bar[XB_TOPGEN]) == tg, bar);
            __builtin_amdgcn_fence(__ATOMIC_ACQUIRE, "agent");
            xb_add(&bar[XB_XGEN(b.x)], 1u);
            asm volatile("s_waitcnt vmcnt(0)" ::: "memory");
        } else {
            XB_SPIN(xb_ld(&bar[XB_XGEN(b.x)]) == gen, bar);
            __builtin_amdgcn_fence(__ATOMIC_ACQUIRE, "agent");
            asm volatile("s_waitcnt vmcnt(0)" ::: "memory");
        }
    }
    __syncthreads();
}

#define PH_LOCALS \
    LAS unsigned char* lds = lds0; asm volatile("" : "+s"(lds)); \
    int tid = threadIdx.x; asm volatile("" : "+v"(tid)); const int lane = tid & 63, wave = __builtin_amdgcn_readfirstlane(tid >> 6); (void)lane; \
    unsigned long long ws_i = (unsigned long long)PWS_, out_i = (unsigned long long)POUT_; asm volatile("" : "+s"(ws_i), "+s"(out_i)); \
    unsigned char* ws = (unsigned char*)(__attribute__((address_space(1))) unsigned char*)ws_i; float* out = (float*)(__attribute__((address_space(1))) float*)out_i; \
    int G = gridDim.x, bxl = blockIdx.x; asm volatile("" : "+s"(G), "+s"(bxl)); const int gw = bxl * 8 + wave, NGW = G * 8; (void)gw; (void)NGW; \
    bf16_t* H = (bf16_t*)(ws + WS_A1); bf16_t* U = H; bf16_t* CQ = (bf16_t*)(ws + WS_CQ); bf16_t* CKV = (bf16_t*)(ws + WS_A2 + 24 * MiB + 512 * 1024); \
    float* RSQ = (float*)(ws + WS_MISC + MI_RSQ); float* RSK = (float*)(ws + WS_MISC + MI_RSK); (void)RSQ; (void)RSK; \
    float* Zs = (float*)(ws + WS_A2); bf16_t* Qm = (bf16_t*)(ws + WS_A2); \
    bf16_t* SA = (bf16_t*)(ws + WS_SA); bf16_t* SB = (bf16_t*)(ws + WS_SB); bf16_t* GA = (bf16_t*)(ws + WS_GA); bf16_t* GB = (bf16_t*)(ws + WS_GB); \
    bf16_t* VTF = (bf16_t*)(ws + WS_VTF); \
    bf16_t* KR = (bf16_t*)(ws + WS_MISC + MI_KR); float* TAB = (float*)(ws + WS_MISC + MI_TAB); float* LOGF = (float*)(ws + WS_MISC + MI_LOGF); \
    float* CUM2 = (float*)(ws + WS_MISC + MI_CUM2); float* CUMS = (float*)(ws + WS_MISC + MI_CUMS); float* KMAX = (float*)(ws + WS_MISC + MI_KMAX); (void)KMAX; \
    bf16_t* Qf = (bf16_t*)(ws + WS_A8 + A8_QF); bf16_t* Kf = (bf16_t*)(ws + WS_A8 + A8_KF); bf16_t* Kn = (bf16_t*)(ws + WS_A8 + A8_KN); bf16_t* VTM = (bf16_t*)(ws + WS_A8 + A8_VTM); \
    float* Ua = (float*)(ws + WS_A8); \
    const bf16_t* Wt_in = (const bf16_t*)(ws + WS_W + W_IN); const bf16_t* Wt_uq = (const bf16_t*)(ws + WS_W + W_UQ); const bf16_t* Wt_uk = (const bf16_t*)(ws + WS_W + W_UK); \
    const bf16_t* Wt_uv = (const bf16_t*)(ws + WS_W + W_UV); const bf16_t* Wt_oa = (const bf16_t*)(ws + WS_W + W_OA); const bf16_t* Wt_ob = (const bf16_t*)(ws + WS_W + W_OB); \
    const bf16_t* Wt_out = (const bf16_t*)(ws + WS_W + W_OUT); \
    const float* xp = PIN_(0); const float* xs = PIN_(1); \
    (void)H; (void)U; (void)CQ; (void)CKV; (void)Zs; (void)Qm; (void)SA; (void)SB; (void)GA; (void)GB; (void)VTF; (void)KR; (void)TAB; (void)LOGF; (void)CUM2; (void)CUMS; (void)Qf; (void)Kf; (void)Kn; (void)VTM; (void)Ua; \
    (void)Wt_in; (void)Wt_uq; (void)Wt_uk; (void)Wt_uv; (void)Wt_oa; (void)Wt_ob; (void)Wt_out; (void)xp; (void)xs; (void)out; (void)G;
__global__ void __launch_bounds__(512, 2) mk_fwd(Params P) {
    extern __shared__ __attribute__((aligned(16))) unsigned char lds_raw[];
    LAS unsigned char* lds0 = (LAS unsigned char*)lds_raw;
    if (threadIdx.x == 0) { LAS unsigned long long* tb = (LAS unsigned long long*)(lds0 + 131072);
        tb[0] = (unsigned long long)P.in[0]; tb[1] = (unsigned long long)P.in[1]; tb[2] = (unsigned long long)P.in[2]; tb[3] = (unsigned long long)P.in[3]; tb[4] = (unsigned long long)P.in[4];
        tb[5] = (unsigned long long)P.in[5]; tb[6] = (unsigned long long)P.in[6]; tb[7] = (unsigned long long)P.in[7]; tb[8] = (unsigned long long)P.in[8]; tb[9] = (unsigned long long)P.in[9];
        tb[10] = (unsigned long long)P.in[10]; tb[11] = (unsigned long long)P.in[11]; tb[12] = (unsigned long long)P.in[12]; tb[13] = (unsigned long long)P.in[13]; tb[14] = (unsigned long long)P.in[14];
        tb[15] = (unsigned long long)P.in[15]; tb[16] = (unsigned long long)P.in[16]; tb[17] = (unsigned long long)P.in[17]; tb[18] = (unsigned long long)P.out; tb[19] = (unsigned long long)P.ws;
        ((LAS unsigned*)(lds0 + 131072 + 640))[0] = 0u; ((LAS unsigned*)(lds0 + 131072 + 640))[1] = 0u; }
    __syncthreads();
    cg::grid_group grid = cg::this_grid();
    const int lo = P.ph_lo, hi_ = P.ph_hi;
#define IN(k) (lo <= (k) && (k) < hi_)
    unsigned* barw = (unsigned*)(P.ws + WS_MISC + MI_BAR);
    XcdBarrier xbar = xcd_barrier_post(barw, (volatile LAS unsigned*)(lds0 + 131072 + 640));
    if (P.ph_lo < 0) grid.sync();
#define SEAM(k) do { if (IN(k) && IN((k) + 1)) xcd_barrier(xbar); } while (0)

    if (IN(0)) { PH_LOCALS

#ifndef T_SKIP_P0
        for (int e = bxl * 512 + tid; e < 2 * MT; e += G * 512) RSQ[e] = 0.f;
        convert_weights(0, lds, gw, NGW, wave, lane);
        for (int r = gw; r < MT; r += 2 * NGW) { const int r2 = r + NGW; const bool h2_ = r2 < MT;
            rms_rows2_1024(r < MP ? xp + (size_t)r * DM : xs + (size_t)(r - MP) * DM, h2_ ? (r2 < MP ? xp + (size_t)r2 * DM : xs + (size_t)(r2 - MP) * DM) : nullptr, PIN_(7), H + (size_t)r * DM, h2_ ? H + (size_t)r2 * DM : nullptr, lane); }
        for (int e = bxl * 512 + tid; e < MP * 16; e += G * 512) { const int pos = e >> 4, i = e & 15;
            const double inv = exp(-9.210340371976184 * (double)i / 16.0); const double rev = (double)pos * inv * 0.15915494309189535; const float fr_ = (float)(rev - rint(rev));
            TAB[(size_t)pos * 32 + i] = __builtin_amdgcn_cosf(fr_); TAB[(size_t)pos * 32 + 16 + i] = __builtin_amdgcn_sinf(fr_); }
#endif

    }
    SEAM(0);
#pragma unroll
    for (int l = 0; l < 2; ++l) {
        const int pb = 1 + 7 * l;
        if (IN(pb)) { PH_LOCALS

#ifndef T_SKIP_P1A
            EpiIn E{CQ, CKV, RSQ, RSK, PIN_(9) + l * 384, PIN_(11) + l * 256, SA, SB, Qf, Kf, GA, GB, KR, LOGF, TAB, PIN_(13) + l * 8, out, l};
            run_gemm(lds, H, Wt_in, MT, NIN, DM, 0, E);
#endif


#ifndef T_SKIP_P1B
            EpiPlain E2{VTF, MT, nullptr, 0};
            run_gemm(lds, Wt_in + (size_t)2816 * DM, H, 512, MT, DM, 88, E2);
#endif

        }
        SEAM(pb);
        if (IN(pb + 2)) { PH_LOCALS

#ifndef T_SKIP_P3
#ifndef T_SKIP_P3A
            EpiQ EQ{Qm, TAB, RSQ}; run_gemm(lds, CQ, Wt_uq, MT, 768, 384, 0, EQ);
#endif
#ifndef T_SKIP_P3B
            EpiPlain EK{Kn, 512, RSK, 1}; run_gemm(lds, CKV, Wt_uk, MP, 512, 256, 200, EK);
#endif
#ifndef T_SKIP_P3C
            EpiPlain EV{VTM, MT, RSK, 2}; run_gemm(lds, Wt_uv, CKV, 512, MP, 256, 328, EV);
#endif
#endif
            { const float* gkv = PIN_(11) + l * 256;
              const f32x4 g = *((const f32x4*)gkv + lane);
              for (int r = gw; r < MT; r += 4 * NGW) {
                  float* zr[4]; f32x4 v[4]; float rs[4];
#pragma unroll
                  for (int j = 0; j < 4; ++j) { const int rr = (r + j * NGW < MT) ? r + j * NGW : r;
                      zr[j] = (rr < MP) ? out + O_PCKV + (size_t)l * MP * 256 + (size_t)rr * 256 : out + O_SCKV + (size_t)l * MSM * 256 + (size_t)(rr - MP) * 256;
                      v[j] = *((const f32x4*)zr[j] + lane); rs[j] = RSK[rr]; }
#pragma unroll
                  for (int j = 0; j < 4; ++j) if (j == 0 || r + j * NGW < MT) *((f32x4*)zr[j] + lane) = v[j] * (1.0f / sqrtf(rs[j] * (1.f / 256.f) + EPSN)) * g; } }
            for (int job = gw; job < 2048; job += NGW) {
                const int hh = job >> 8, tt = job & 255; const bf16_t* kr_ = Kf + (size_t)(tt * 64 + lane) * 512 + hh * 64; float ss = 0.f;
#pragma unroll
                for (int c = 0; c < 8; ++c) { f32x4 a0, a1; ld8b(kr_ + c * 8, a0, a1); ss += (a0[0] * a0[0] + a0[1] * a0[1]) + (a0[2] * a0[2] + a0[3] * a0[3]) + (a1[0] * a1[0] + a1[1] * a1[1]) + (a1[2] * a1[2] + a1[3] * a1[3]); }
                const float nm = wave_max(sqrtf(ss) * 1.002f); if (lane == 0) KMAX[job] = nm; }
            for (int hh = bxl; hh < 8; hh += G) {
                LAS double* part = (LAS double*)lds; double loc = 0.0; float vals[32];
#pragma unroll
                for (int i = 0; i < 32; ++i) { vals[i] = LOGF[(size_t)(tid * 32 + i) * 8 + hh]; loc += (double)vals[i]; }
                double inc = loc;
#pragma unroll
                for (int o = 1; o < 64; o <<= 1) { const double t_ = __shfl_up(inc, o); if (lane >= o) inc += t_; }
                if (lane == 63) part[wave] = inc;
                __syncthreads();
                double pre = inc - loc; for (int w2 = 0; w2 < wave; ++w2) pre += part[w2];
#pragma unroll
                for (int i = 0; i < 32; ++i) { pre += (double)vals[i]; CUM2[(size_t)hh * MP + tid * 32 + i] = (float)(pre * 1.4426950408889634); }
                __syncthreads();
            }
            for (int jw = NGW - 1 - gw; jw < 128; jw += NGW) {
                const int b = jw >> 3, hh = jw & 7; const float* cl = PIN_(6) + (size_t)l * 16 * PAST * 8 + (size_t)b * PAST * 8 + hh;
                float vals[17]; double loc = 0.0;
#pragma unroll
                for (int i = 0; i < 17; ++i) { const int j = lane * 17 + i; float v = 0.f; if (j < PAST) v = cl[(size_t)j * 8]; else if (j < TKEYS) v = LOGF[(size_t)(MP + b * 16 + j - PAST) * 8 + hh]; vals[i] = v; loc += (double)v; }
                double inc = loc;
#pragma unroll
                for (int o = 1; o < 64; o <<= 1) { const double t_ = __shfl_up(inc, o); if (lane >= o) inc += t_; }
                double pre = inc - loc;
#pragma unroll
                for (int i = 0; i < 17; ++i) { const int j = lane * 17 + i; pre += (double)vals[i]; if (j < TKEYS) CUMS[(size_t)jw * TKEYS + j] = (float)pre; }
            }

        }
        SEAM(pb + 2);
        if (IN(pb + 3)) { PH_LOCALS
            const int vcu = (G % 8 == 0) ? (bxl % 8) * (G / 8) + bxl / 8 : bxl;
            for (int it = vcu; it < 768; it += G) {
                int tid2 = threadIdx.x; asm volatile("" : "+v"(tid2)); LAS unsigned char* lds2 = lds0; asm volatile("" : "+s"(lds2));
                const int ty = it >> 8, idx = it & 255;

#ifndef T_SKIP_P4A
                if (ty == 0) { AttnP a{Qf, Kf, nullptr, VTF, MT, CUM2, SB, KMAX, SB}; const int hh = idx >> 5, s = idx & 31;
                    attn_unit_prompt<64, true>(a, hh, 63 - s, lds2, tid2); __syncthreads(); attn_unit_prompt<64, true>(a, hh, s, lds2, tid2); __syncthreads(); }
#endif


#ifndef T_SKIP_P4B
                if (ty == 1) { AttnP a{Qm, Kn, KR, VTM, MT, nullptr, SA, nullptr, SA}; const int hh = idx >> 5, s = idx & 31;
                    attn_unit_prompt<96, false>(a, hh, 63 - s, lds2, tid2); __syncthreads(); attn_unit_prompt<96, false>(a, hh, s, lds2, tid2); __syncthreads(); }
#endif


#ifndef T_SKIP_P4C
                if (ty == 2) { if (idx < 128) sample_mla_unit(l, idx >> 3, idx & 7, lds2, tid2); else sample_fox_unit(l, (idx - 128) >> 3, idx & 7, lds2, tid2); }
#endif

            }
        }
        SEAM(pb + 3);
        if (IN(pb + 4)) { PH_LOCALS

#ifndef T_SKIP_P5
            for (int blk = bxl; blk < 256; blk += G) {
                const int rb = blk >> 5, cb = blk & 31, row0 = MP + 32 * rb, col0 = 32 * cb, r32 = lane & 31, hi = lane >> 5;
                LAS float* PA = (LAS float*)lds; LAS float* PB = (LAS float*)(lds + 32768);
                const f32x16 accA = mini_acc<4>(SA + (size_t)row0 * 512, 512, Wt_oa + (size_t)col0 * 512, 512, wave, r32, hi);
                const f32x16 accB = mini_acc<4>(SB + (size_t)row0 * 512, 512, Wt_ob + (size_t)col0 * 512, 512, wave, r32, hi);
                mini_put(PA, accA, wave, r32, hi); mini_put(PB, accB, wave, r32, hi);
                __syncthreads();
                for (int e = tid; e < 1024; e += 512) { const int i_ = e >> 5, j_ = e & 31; const size_t idx = (size_t)(row0 + i_) * 1024 + col0 + j_;
                    U[idx] = (bf16_t)f2bf(bf2f(GA[idx]) * mini_sum(PA, i_, j_) + bf2f(GB[idx]) * mini_sum(PB, i_, j_)); }
                __syncthreads();
            }
            EpiGateA EA{GA, U}; run_gemm(lds, SA, Wt_oa, MP, DM, 512, 0, EA);
            EpiGateB EB{GB, U}; run_gemm(lds, SB, Wt_ob, MP, DM, 512, 0, EB);
#endif

        }
        SEAM(pb + 4);
        if (IN(pb + 5)) { PH_LOCALS
#ifndef T_SKIP_P6
for (int blk = bxl; blk < 256; blk += G) {
                const int rb = blk >> 5, cb = blk & 31, row0 = MP + 32 * rb, col0 = 32 * cb, r32 = lane & 31, hi = lane >> 5;
                LAS float* PA = (LAS float*)lds;
                const f32x16 accA = mini_acc<8>(U + (size_t)row0 * 1024, 1024, Wt_out + (size_t)col0 * 1024, 1024, wave, r32, hi);
                mini_put(PA, accA, wave, r32, hi);
                __syncthreads();
                for (int e = tid; e < 1024; e += 512) { const int i_ = e >> 5, j_ = e & 31; const size_t idx = (size_t)(row0 + i_) * 1024 + col0 + j_;
                    const float res = (l == 0) ? xs[(size_t)(row0 - MP + i_) * 1024 + col0 + j_] : out[O_Y + idx];
                    out[O_Y + idx] = res + mini_sum(PA, i_, j_); }
                __syncthreads();
            }
            EpiOut EO{xp, xs, out + O_Y, l}; run_gemm(lds, U, Wt_out, MP, DM, DM, 0, EO);
#endif
 }
        SEAM(pb + 5);
        if (IN(pb + 6)) { PH_LOCALS

#ifndef T_SKIP_P7
            if (l == 0) { convert_weights(1, lds, gw, NGW, wave, lane);
                for (int e = bxl * 512 + tid; e < 2 * MT; e += G * 512) RSQ[e] = 0.f;
                for (int r = gw; r < MT; r += 2 * NGW) { const int r2 = r + NGW; const bool h2_ = r2 < MT;
                    rms_rows2_1024(out + O_Y + (size_t)r * DM, h2_ ? out + O_Y + (size_t)r2 * DM : nullptr, PIN_(7) + DM, H + (size_t)r * DM, h2_ ? H + (size_t)r2 * DM : nullptr, lane); } }
            else { for (int r = gw; r < MT; r += 2 * NGW) { const int r2 = r + NGW; rms_rows2_f32(out + O_Y + (size_t)r * DM, r2 < MT ? out + O_Y + (size_t)r2 * DM : nullptr, PIN_(17), lane); } }
#endif

        }
        if (l == 0) SEAM(pb + 6);
    }
#undef IN
#undef SEAM
}

extern "C" void kernel_launch(void* const* d_in, const int* in_sizes, int n_in, void* d_out, int out_size, void* d_ws, size_t ws_size, hipStream_t stream) {
    static int grid = 0;
    if (grid == 0) {
        if (n_in != 18 || out_size != (int)O_TOTAL || ws_size < WS_END) { fprintf(stderr, "kernel_launch: unexpected shapes (n_in %d, out %d, ws %zu)\n", n_in, out_size, ws_size); grid = -1; return; }
        int dev = 0, cus = 0, per_cu = 0;
        hipGetDevice(&dev); hipDeviceGetAttribute(&cus, hipDeviceAttributeMultiprocessorCount, dev);
        hipFuncSetAttribute((const void*)mk_fwd, hipFuncAttributeMaxDynamicSharedMemorySize, LDS_BYTES);
        hipOccupancyMaxActiveBlocksPerMultiprocessor(&per_cu, (const void*)mk_fwd, 512, LDS_BYTES);
        (void)hipGetLastError();
        if (per_cu < 1) per_cu = 1;
        grid = cus * 1;
        if (grid <= 0) grid = 256;
    }
    if (grid < 0) return;
    Params p{};
    for (int i = 0; i < 18; ++i) p.in[i] = (const float*)d_in[i];
    p.out = (float*)d_out; p.ws = (unsigned char*)d_ws;
#if MK_MULTI
    for (int ph = 0; ph < 15; ++ph) { p.ph_lo = ph; p.ph_hi = ph + 1; hipLaunchKernelGGL(mk_fwd, dim3(grid), dim3(512), LDS_BYTES, stream, p); }
#else
    p.ph_lo = 0; p.ph_hi = 15;
    if (hipMemsetAsync((char*)d_ws + WS_MISC + MI_BAR, 0, XCD_BAR_WORDS * 4, stream) != hipSuccess) { fprintf(stderr, "kernel_launch: memset of the barrier words failed\n"); return; }
    void* args[] = {&p};
    hipError_t e = hipLaunchCooperativeKernel((const void*)mk_fwd, dim3(grid), dim3(512), args, LDS_BYTES, stream);
    if (e != hipSuccess) fprintf(stderr, "cooperative launch failed: %s (grid %d)\n", hipGetErrorString(e), grid);
#endif
}
```

```cpp
#include <hip/hip_runtime.h>
#include <hip/hip_cooperative_groups.h>
#include <cstdio>
#include <cstdint>
namespace cg = cooperative_groups;
namespace pg8 {
#define PG8_LAS __attribute__((address_space(3)))
typedef unsigned short bf16_t;
typedef short bf16x8 __attribute__((ext_vector_type(8)));
typedef float f32x4 __attribute__((ext_vector_type(4)));
typedef unsigned u32x4 __attribute__((ext_vector_type(4)));
constexpr int BM = 256, BK = 64, HALF = 128, HTB = HALF * BK * 2  , STAGE_BYTES = 8 * HTB, NXCD = 8, WGM = 8;

__host__ __device__ __forceinline__ int lds_byte(int r, int c) { const int st = (r >> 4) * 2 + (c >> 5), rr = r & 15, cc = c & 31, ob = rr * 64 + cc * 2; return st * 1024 + (ob ^ (((ob >> 9) & 1) << 5)); }
__host__ __device__ __forceinline__ void stage_rc(int b, int& R, int& C) { const int st = b / 1024, sb = b % 1024, swz = sb ^ (((sb >> 9) & 1) << 5); R = (st >> 1) * 16 + swz / 64; C = (st & 1) * 32 + (swz % 64) / 2; }
__host__ __device__ __forceinline__ int perm32(int rho) { const int n = rho >> 4, i = rho & 15; return 8 * (i >> 2) + 4 * n + (i & 3); }

struct Unit { int pm, pn; };
struct Gemm { const bf16_t* A; const bf16_t* Bt; int M, N, K; };

struct StaticOrder {
    int nM, nN, nwg, G, c;
    __host__ __device__ void init(int M, int N, int G_, int c_) { nM = M / BM; nN = N / BM; nwg = nM * nN; G = G_; c = c_; }
    __host__ __device__ bool next(int i, Unit& u) const {
        const long L = (long)i * G + c; if (L >= nwg) return false;
        int wgid = (int)L; { const int q = nwg / NXCD, r = nwg % NXCD, xcd = wgid % NXCD, off = wgid / NXCD; wgid = (xcd < r ? xcd * (q + 1) : r * (q + 1) + (xcd - r) * q) + off; }
        const int nig = WGM * nN, gid = wgid / nig, fm = gid * WGM, gsz = (nM - fm) < WGM ? (nM - fm) : WGM;
        u.pm = fm + ((wgid % nig) % gsz); u.pn = (wgid % nig) / gsz; return true;
    }
    __device__ __forceinline__ void a_ready(const Unit&) const {}
    __device__ __forceinline__ void done(const Unit&) const {}
};

__device__ __forceinline__ unsigned cvt_pk_bf16(float lo, float hi) { unsigned r; asm volatile("v_cvt_pk_bf16_f32 %0, %1, %2" : "=v"(r) : "v"(lo), "v"(hi)); return r; }
typedef float f32x2 __attribute__((ext_vector_type(2)));
template <class Epi, class Sched, bool ALIGN_EPI = false, bool SP2 = false>
__device__ __forceinline__ void gemm_phase(PG8_LAS unsigned char* lds, const Gemm g, const Sched& S, const Epi& E) {
    int tid_ = threadIdx.x; asm volatile("" : "+v"(tid_));
    const int tid = tid_, wid = __builtin_amdgcn_readfirstlane(tid >> 6), lane = tid & 63, wr = wid >> 2, wc = wid & 3, fr = lane & 15, fq = lane >> 4;
    const int K = g.K, nt = K / BK;
    unsigned voffA[2], voffB[2];
#pragma unroll
    for (int i = 0; i < 2; ++i) { int R, C; stage_rc(tid * 16 + i * 8192, R, C); const int Rb = Epi::PERM ? ((R & ~31) + perm32(R & 31)) : R;
        voffA[i] = (unsigned)(R * K + C) * 2u; voffB[i] = (unsigned)(Rb * K + C) * 2u; }
    const size_t kstep = (size_t)(BK * 2);
    const size_t hstep = (size_t)HALF * K * 2;
    const size_t tstep = 2 * hstep;
    const unsigned ldsw = (unsigned)wid * 1024u;
    const int aoff = lds_byte(wr * 64 + fr, fq * 8), boff = lds_byte(wc * 32 + fr, fq * 8);
#define PG8_SA(b, h) (((b) * 2 + (h)) * HTB)
#define PG8_SB(b, h) ((4 + (b) * 2 + (h)) * HTB)
#define PG8_STAGE(bufoff, gbase, voff) do { _Pragma("unroll") for (int _i = 0; _i < 2; ++_i) \
        __builtin_amdgcn_global_load_lds((const unsigned*)((const char*)(gbase) + (voff)[_i]), (PG8_LAS unsigned*)(lds + (bufoff) + ldsw + _i * 8192), 16, 0, 0); } while (0)
#define PG8_LDA(dst, b, h) do { _Pragma("unroll") for (int m = 0; m < 4; ++m) _Pragma("unroll") for (int k = 0; k < 2; ++k) dst[m][k] = *(const PG8_LAS bf16x8*)(lds + PG8_SA(b, h) + aoff + m * 2048 + k * 1024); } while (0)
#define PG8_LDB(dst, b, h) do { _Pragma("unroll") for (int n = 0; n < 2; ++n) _Pragma("unroll") for (int k = 0; k < 2; ++k) dst[n][k] = *(const PG8_LAS bf16x8*)(lds + PG8_SB(b, h) + boff + n * 2048 + k * 1024); } while (0)
#define PG8_MMA(ai, bj, At, Bt) do { __builtin_amdgcn_s_setprio(1); _Pragma("unroll") for (int m = 0; m < 4; ++m) _Pragma("unroll") for (int n = 0; n < 2; ++n) _Pragma("unroll") for (int k = 0; k < 2; ++k) \
        acc[ai][bj][m][n] = __builtin_amdgcn_mfma_f32_16x16x32_bf16(Bt[n][k], At[m][k], acc[ai][bj][m][n], 0, 0, 0); __builtin_amdgcn_s_setprio(0); } while (0)
#define PG8_WAIT_V(n) asm volatile("s_waitcnt vmcnt(" #n ")" ::: "memory")
#define PG8_WAIT_L(n) asm volatile("s_waitcnt lgkmcnt(" #n ")" ::: "memory")
#define PG8_BAR __builtin_amdgcn_s_barrier()
#define PG8_SCHED __builtin_amdgcn_sched_barrier(0)
    Unit cur, nxt; int ui = 0;
    if (!S.next(0, cur)) return;
    f32x4 acc[2][2][4][2];
#pragma unroll
    for (int a = 0; a < 2; ++a)
#pragma unroll
        for (int b = 0; b < 2; ++b)
#pragma unroll
            for (int m = 0; m < 4; ++m)
#pragma unroll
                for (int n = 0; n < 2; ++n) acc[a][b][m][n] = (f32x4){0.f, 0.f, 0.f, 0.f};
    bf16x8 At[4][2], B0[2][2], B1[2][2];
    const char* cA = (const char*)g.A + (size_t)cur.pm * tstep; const char* cB = (const char*)g.Bt + (size_t)cur.pn * tstep;
    S.a_ready(cur);
    if constexpr (SP2) {
        PG8_STAGE(PG8_SB(0, 0), cB, voffB); PG8_STAGE(PG8_SB(0, 1), cB + hstep, voffB); PG8_STAGE(PG8_SA(0, 0), cA, voffA); PG8_STAGE(PG8_SA(0, 1), cA + hstep, voffA);
        if (wr == 1) PG8_BAR;
        PG8_WAIT_V(2); PG8_BAR;
        PG8_STAGE(PG8_SB(1, 0), cB + kstep, voffB); PG8_STAGE(PG8_SA(1, 0), cA + kstep, voffA); PG8_STAGE(PG8_SB(1, 1), cB + hstep + kstep, voffB);
        PG8_WAIT_V(6); PG8_BAR;
    } else {
        PG8_STAGE(PG8_SB(0, 0), cB, voffB); PG8_STAGE(PG8_SA(0, 0), cA, voffA); PG8_STAGE(PG8_SB(0, 1), cB + hstep, voffB); PG8_STAGE(PG8_SA(0, 1), cA + hstep, voffA);
        if (wr == 1) PG8_BAR;
        PG8_WAIT_V(4); PG8_BAR;
        PG8_STAGE(PG8_SB(1, 0), cB + kstep, voffB); PG8_STAGE(PG8_SA(1, 0), cA + kstep, voffA); PG8_STAGE(PG8_SB(1, 1), cB + hstep + kstep, voffB);
        PG8_WAIT_V(6); PG8_BAR;
    }
    for (;;) {
        const bool has_next = S.next(ui + 1, nxt);
        const char* nA = has_next ? (const char*)g.A + (size_t)nxt.pm * tstep : cA; const char* nB = has_next ? (const char*)g.Bt + (size_t)nxt.pn * tstep : cB;
        for (int t = 0; t < nt; t += 2) {
            const bool last = (t == nt - 2);
            const char* a1 = cA + (size_t)(t + 1) * kstep;
            const char* a2 = last ? nA : cA + (size_t)(t + 2) * kstep; const char* b2 = last ? nB : cB + (size_t)(t + 2) * kstep;
            const char* a3 = a2 + kstep; const char* b3 = b2 + kstep;
            if (last && has_next) S.a_ready(nxt);
            if constexpr (SP2) {
            PG8_LDB(B0, 0, 0); PG8_LDB(B1, 0, 1); PG8_SCHED; PG8_LDA(At, 0, 0); PG8_STAGE(PG8_SA(1, 1), a1 + hstep, voffA);
            PG8_WAIT_V(8); PG8_WAIT_L(0); PG8_BAR; PG8_MMA(0, 0, At, B0); PG8_MMA(0, 1, At, B1); PG8_BAR; PG8_SCHED;
            PG8_LDA(At, 0, 1); PG8_STAGE(PG8_SB(0, 0), b2, voffB); PG8_STAGE(PG8_SB(0, 1), b2 + hstep, voffB); PG8_STAGE(PG8_SA(0, 0), a2, voffA);
            PG8_WAIT_V(8); PG8_WAIT_L(0); PG8_BAR; PG8_MMA(1, 0, At, B0); PG8_MMA(1, 1, At, B1); PG8_BAR; PG8_SCHED;
            PG8_LDB(B0, 1, 0); PG8_LDB(B1, 1, 1); PG8_SCHED; PG8_LDA(At, 1, 0); PG8_STAGE(PG8_SA(0, 1), a2 + hstep, voffA);
            PG8_WAIT_V(8); PG8_WAIT_L(0); PG8_BAR; PG8_MMA(0, 0, At, B0); PG8_MMA(0, 1, At, B1); PG8_BAR; PG8_SCHED;
            PG8_LDA(At, 1, 1); PG8_STAGE(PG8_SB(1, 0), b3, voffB); PG8_STAGE(PG8_SB(1, 1), b3 + hstep, voffB); PG8_STAGE(PG8_SA(1, 0), a3, voffA);
            PG8_WAIT_V(8); PG8_WAIT_L(0); PG8_BAR; PG8_MMA(1, 0, At, B0); PG8_MMA(1, 1, At, B1); PG8_BAR; PG8_SCHED;
            } else {
            PG8_LDB(B0, 0, 0); PG8_SCHED; PG8_LDA(At, 0, 0); PG8_STAGE(PG8_SA(1, 1), a1 + hstep, voffA);
            PG8_WAIT_L(8); PG8_BAR; PG8_WAIT_L(0); PG8_MMA(0, 0, At, B0); PG8_BAR; PG8_SCHED;
            PG8_LDB(B1, 0, 1); PG8_STAGE(PG8_SB(0, 0), b2, voffB);
            PG8_BAR; PG8_WAIT_L(0); PG8_MMA(0, 1, At, B1); PG8_BAR;
            PG8_LDA(At, 0, 1); PG8_STAGE(PG8_SA(0, 0), a2, voffA);
            PG8_BAR; PG8_WAIT_L(0); PG8_MMA(1, 0, At, B0); PG8_BAR; PG8_SCHED;
            PG8_STAGE(PG8_SB(0, 1), b2 + hstep, voffB);
            PG8_WAIT_V(6); PG8_BAR; PG8_MMA(1, 1, At, B1); PG8_BAR;
            PG8_LDB(B0, 1, 0); PG8_SCHED; PG8_LDA(At, 1, 0); PG8_STAGE(PG8_SA(0, 1), a2 + hstep, voffA);
            PG8_WAIT_L(8); PG8_BAR; PG8_WAIT_L(0); PG8_MMA(0, 0, At, B0); PG8_BAR; PG8_SCHED;
            PG8_LDB(B1, 1, 1); PG8_STAGE(PG8_SB(1, 0), b3, voffB);
            PG8_BAR; PG8_WAIT_L(0); PG8_MMA(0, 1, At, B1); PG8_BAR;
            PG8_LDA(At, 1, 1); PG8_STAGE(PG8_SA(1, 0), a3, voffA);
            PG8_BAR; PG8_WAIT_L(0); PG8_MMA(1, 0, At, B0); PG8_BAR; PG8_SCHED;
            PG8_STAGE(PG8_SB(1, 1), b3 + hstep, voffB);
            PG8_WAIT_V(6); PG8_BAR; PG8_MMA(1, 1, At, B1); PG8_BAR;
            }
        }
        if constexpr (ALIGN_EPI) { if (wr == 0) PG8_BAR; }
        if constexpr (!Epi::AFTER_DRAIN) { E(acc, cur, wr, wc, fr, fq); S.done(cur); }
        if (!has_next) break;
#pragma unroll
        for (int a = 0; a < 2; ++a)
#pragma unroll
            for (int b = 0; b < 2; ++b)
#pragma unroll
                for (int m = 0; m < 4; ++m)
#pragma unroll
                    for (int n = 0; n < 2; ++n) acc[a][b][m][n] = (f32x4){0.f, 0.f, 0.f, 0.f};
        cur = nxt; cA = nA; cB = nB; ++ui;
        if constexpr (ALIGN_EPI) { if (wr == 1) PG8_BAR; }
    }
    PG8_WAIT_V(0);
    if constexpr (!ALIGN_EPI) { if (wr == 0) PG8_BAR; }
    PG8_BAR;
    if constexpr (Epi::AFTER_DRAIN) { E.fused(acc, cur, wr, wc, fr, fq, lds, wid, lane); S.done(cur); }
#undef PG8_SA
#undef PG8_SB
#undef PG8_STAGE
#undef PG8_LDA
#undef PG8_LDB
#undef PG8_MMA
#undef PG8_WAIT_V
#undef PG8_WAIT_L
#undef PG8_BAR
#undef PG8_SCHED
}
}

#ifndef MK_MULTI
#define MK_MULTI 0
#endif
#define LAS __attribute__((address_space(3)))
using pg8::bf16_t; using pg8::bf16x8; using pg8::f32x4; using pg8::u32x4; using pg8::Unit;
typedef float f32x16 __attribute__((ext_vector_type(16)));
typedef float f32x2v __attribute__((ext_vector_type(2)));
typedef unsigned u32x2 __attribute__((ext_vector_type(2)));

constexpr int MP = 16384, MSM = 256, MT = MP + MSM;
constexpr int DM = 1024, NIN = 5376, NINSRC = 5288;
constexpr int PAST = 1024, TKEYS = 1040;
constexpr float LOG2E = 1.4426950408889634f;
constexpr float C2F = 0.125f * LOG2E;
constexpr float C2M = 0.10206207261596577f * LOG2E;
constexpr float EPSN = 1e-6f;
constexpr float NEGB = -1e30f;

constexpr size_t MiB = 1u << 20;
constexpr size_t WS_W = 0;
constexpr size_t W_IN = 0, W_UQ = 11 * MiB, W_UK = 11 * MiB + 768 * 1024, W_UV = 12 * MiB, W_OA = 12 * MiB + 512 * 1024, W_OB = 13 * MiB + 512 * 1024, W_OUT = 14 * MiB + 512 * 1024;
constexpr size_t WS_A1 = 17 * MiB;
constexpr size_t WS_A2 = 50 * MiB;
constexpr size_t WS_SA = 83 * MiB, WS_SB = 99 * MiB + 512 * 1024;
constexpr size_t WS_GA = 116 * MiB, WS_GB = 149 * MiB;
constexpr size_t WS_VTF = 182 * MiB;
constexpr size_t WS_MISC = 198 * MiB + 512 * 1024;
constexpr size_t MI_KR = 0, MI_TAB = MiB + 256 * 1024, MI_LOGF = 3 * MiB + 256 * 1024, MI_CUM2 = 4 * MiB, MI_CUMS = 4 * MiB + 512 * 1024, MI_KMAX = 5 * MiB + 256 * 1024, MI_BAR = 5 * MiB + 320 * 1024, MI_QCNT = MI_BAR + 14336  , MI_RSQ = 5 * MiB + 336 * 1024, MI_RSK = MI_RSQ + 66560;
constexpr size_t WS_A8 = 204 * MiB;
constexpr size_t A8_QF = 0, A8_KF = 16 * MiB + 256 * 1024, A8_KN = 32 * MiB + 512 * 1024, A8_VTM = 48 * MiB + 512 * 1024;
constexpr size_t WS_CQ = 269 * MiB;
constexpr size_t WS_END = 282 * MiB;

constexpr size_t O_Y = 0, O_PCKV = 17039360, O_PKR = 25427968, O_PFK = 26476544, O_PFV = 43253760, O_PLF = 60030976,
                 O_SCKV = 60293120, O_SKR = 60424192, O_SFK = 60440576, O_SFV = 60702720, O_SLF = 60964864, O_TOTAL = 60968960;

constexpr int LDS_BYTES = 132096;

struct Params { const float* in[18]; float* out; unsigned char* ws; int ph_lo, ph_hi; };

__device__ __forceinline__ float bf2f(unsigned short u) { return __uint_as_float((unsigned)u << 16); }
__device__ __forceinline__ unsigned f2bf(float f) { unsigned u = __builtin_bit_cast(unsigned, f); return (u + 0x7fffu + ((u >> 16) & 1u)) >> 16; }
__device__ __forceinline__ unsigned pk2(float lo, float hi) { return f2bf(lo) | (f2bf(hi) << 16); }
__device__ __forceinline__ float wave_sum(float v) {
#pragma unroll
    for (int o = 1; o < 64; o <<= 1) v += __shfl_xor(v, o);
    return v;
}
__device__ __forceinline__ float wave_max(float v) {
#pragma unroll
    for (int o = 1; o < 64; o <<= 1) v = fmaxf(v, __shfl_xor(v, o));
    return v;
}
__device__ __forceinline__ float sigmoidf_(float x) { return __builtin_amdgcn_rcpf(1.0f + __builtin_amdgcn_exp2f(x * -1.4426950408889634f)); }


__device__ __forceinline__ const float* ldptr(LAS unsigned char* lds, int k) {
    const LAS unsigned* t = (const LAS unsigned*)(lds + 131072) + 2 * k; const unsigned lo = __builtin_amdgcn_readfirstlane(t[0]), hi = __builtin_amdgcn_readfirstlane(t[1]);
    return (const float*)(const __attribute__((address_space(1))) float*)(((unsigned long long)hi << 32) | (unsigned long long)lo);
}
#define PIN_(k) ldptr(lds, (k))
#define POUT_ ((float*)ldptr(lds, 18))
#define PWS_ ((unsigned char*)ldptr(lds, 19))
#define EPI_FOREACH(...) \
    _Pragma("unroll") for (int ai = 0; ai < 2; ++ai) _Pragma("unroll") for (int m = 0; m < 4; ++m) { \
        int rt = ai * 128 + wr * 64 + m * 16 + fr; asm volatile("" : "+v"(rt)); const int row = u.pm * 256 + rt; (void)row; \
        _Pragma("unroll") for (int bj = 0; bj < 2; ++bj) { f32x4 v0 = acc[ai][bj][m][0], v1 = acc[ai][bj][m][1]; int ct = bj * 128 + wc * 32 + fq * 8; asm volatile("" : "+v"(ct)); __VA_ARGS__ } asm volatile("" ::: "memory"); }

__device__ __forceinline__ void st8f(float* p, f32x4 a, f32x4 b) { *(f32x4*)p = a; *(f32x4*)(p + 4) = b; }
__device__ __forceinline__ void st8b(bf16_t* p, f32x4 a, f32x4 b) { u32x4 w; w.x = pg8::cvt_pk_bf16(a[0], a[1]); w.y = pg8::cvt_pk_bf16(a[2], a[3]); w.z = pg8::cvt_pk_bf16(b[0], b[1]); w.w = pg8::cvt_pk_bf16(b[2], b[3]); *(u32x4*)p = w; }
__device__ __forceinline__ void ld8b(const bf16_t* p, f32x4& a, f32x4& b) { const u32x4 w = *(const u32x4*)p;
    a[0] = __uint_as_float(w.x << 16); a[1] = __uint_as_float(w.x & 0xffff0000u); a[2] = __uint_as_float(w.y << 16); a[3] = __uint_as_float(w.y & 0xffff0000u);
    b[0] = __uint_as_float(w.z << 16); b[1] = __uint_as_float(w.z & 0xffff0000u); b[2] = __uint_as_float(w.w << 16); b[3] = __uint_as_float(w.w & 0xffff0000u); }

__device__ __forceinline__ void rope8(f32x4& v0, f32x4& v1, const float* tabrow, int fq) {
    const int i0 = (fq & 1) * 8;
    const f32x4 c0 = *(const f32x4*)(tabrow + i0), c1 = *(const f32x4*)(tabrow + i0 + 4), s0 = *(const f32x4*)(tabrow + 16 + i0), s1 = *(const f32x4*)(tabrow + 16 + i0 + 4);
    f32x4 p0, p1;
#pragma unroll
    for (int j = 0; j < 4; ++j) { p0[j] = __shfl_xor(v0[j], 32); p1[j] = __shfl_xor(v1[j], 32); }
    if (fq < 2) { v0 = v0 * c0 - p0 * s0; v1 = v1 * c1 - p1 * s1; }
    else        { v0 = p0 * s0 + v0 * c0; v1 = p1 * s1 + v1 * c1; }
}

#define CQ_PART(col_) do { const int c_ = (col_); float ss_ = (v0[0] * v0[0] + v0[1] * v0[1]) + (v0[2] * v0[2] + v0[3] * v0[3]) + (v1[0] * v1[0] + v1[1] * v1[1]) + (v1[2] * v1[2] + v1[3] * v1[3]); \
        ss_ += __shfl_xor(ss_, 16); ss_ += __shfl_xor(ss_, 32); if (fq == 0) atomicAdd(RSQ + row, ss_); \
        const f32x4 g0_ = *(const f32x4*)(gq + c_), g1_ = *(const f32x4*)(gq + c_ + 4); st8b(CQ + (size_t)row * 384 + c_, v0 * g0_, v1 * g1_); } while (0)
struct EpiIn {
    static constexpr bool PERM = true, AFTER_DRAIN = false;
    bf16_t *CQ, *CKV; float *RSQ, *RSK; const float *gq, *gkv; bf16_t *SA, *SB, *Qf, *Kf, *GA, *GB, *KR; float* LOGF; const float* TAB; const float* bfv; float* out; int layer;
    __device__ __forceinline__ void operator()(const f32x4 (&acc)[2][2][4][2], const Unit& u, int wr, int wc, int fr, int fq) const {
        const int pn = u.pn; const bool samp = (u.pm == 64); const int L = layer;
        if (pn == 0) { EPI_FOREACH( CQ_PART(ct); ) }
        else if (pn == 1) {
            EPI_FOREACH(
                if (bj == 0) { CQ_PART(256 + ct); }
                else if (wc == 0) {
                    const int pos = samp ? (PAST + (rt & 15)) : row;
                    rope8(v0, v1, TAB + (size_t)pos * 32, fq);
                    float* o = samp ? (out + O_SKR + (size_t)L * MSM * 32 + (size_t)rt * 32) : (out + O_PKR + (size_t)L * MP * 32 + (size_t)row * 32);
                    st8f(o + fq * 8, v0, v1); st8b(KR + (size_t)row * 32 + fq * 8, v0, v1);
                } else if (wc == 1 && fq == 0) {
                    float lf[8];
                    _Pragma("unroll")
                    for (int j = 0; j < 8; ++j) { const float x = (j < 4 ? v0[j] : v1[j - 4]) + bfv[j]; lf[j] = fminf(x, 0.f) - log1pf(expf(-fabsf(x))); }
                    float* o = samp ? (out + O_SLF + (size_t)L * MSM * 8 + (size_t)rt * 8) : (out + O_PLF + (size_t)L * MP * 8 + (size_t)row * 8);
                    const f32x4 a = {lf[0], lf[1], lf[2], lf[3]}, b = {lf[4], lf[5], lf[6], lf[7]};
                    st8f(o, a, b); st8f(LOGF + (size_t)row * 8, a, b);
                }
            )
        }
        else if (pn == 2) { float* o = samp ? (out + O_SCKV + (size_t)L * MSM * 256) : (out + O_PCKV + (size_t)L * MP * 256);
            EPI_FOREACH( st8f(o + (size_t)(samp ? rt : row) * 256 + ct, v0, v1);
                { float ss_ = (v0[0] * v0[0] + v0[1] * v0[1]) + (v0[2] * v0[2] + v0[3] * v0[3]) + (v1[0] * v1[0] + v1[1] * v1[1]) + (v1[2] * v1[2] + v1[3] * v1[3]); ss_ += __shfl_xor(ss_, 16); ss_ += __shfl_xor(ss_, 32);
                  if (fq == 0) atomicAdd(RSK + row, ss_);
                  const f32x4 g0_ = *(const f32x4*)(gkv + ct), g1_ = *(const f32x4*)(gkv + ct + 4); st8b(CKV + (size_t)row * 256 + ct, v0 * g0_, v1 * g1_); } ) }
        else if (pn < 7) { bf16_t* o = (pn < 5) ? SA : SB; const int cb = ((pn - 3) & 1) * 256;
            EPI_FOREACH(
                _Pragma("unroll")
                for (int j = 0; j < 4; ++j) { v0[j] = v0[j] * sigmoidf_(v0[j]); v1[j] = v1[j] * sigmoidf_(v1[j]); }
                st8b(o + (size_t)row * 512 + cb + ct, v0, v1); ) }
        else if (pn < 9) { const int cb = (pn - 7) * 256;
            EPI_FOREACH( v0 = v0 * C2F; v1 = v1 * C2F; st8b(Qf + (size_t)row * 512 + cb + ct, v0, v1); ) }
        else if (pn < 11) { const int cb = (pn - 9) * 256; float* o = samp ? (out + O_SFK + (size_t)L * MSM * 512) : (out + O_PFK + (size_t)L * MP * 512);
            EPI_FOREACH( st8f(o + (size_t)(samp ? rt : row) * 512 + cb + ct, v0, v1); st8b(Kf + (size_t)row * 512 + cb + ct, v0, v1); ) }
        else if (pn < 13) { const int cb = (pn - 11) * 256; float* o = samp ? (out + O_SFV + (size_t)L * MSM * 512) : (out + O_PFV + (size_t)L * MP * 512);
            EPI_FOREACH( st8f(o + (size_t)(samp ? rt : row) * 512 + cb + ct, v0, v1); ) }
        else { bf16_t* o = (pn < 17) ? GA : GB; const int cb = ((pn - 13) & 3) * 256;
            EPI_FOREACH(
                _Pragma("unroll")
                for (int j = 0; j < 4; ++j) { v0[j] = sigmoidf_(v0[j]); v1[j] = sigmoidf_(v1[j]); }
                st8b(o + (size_t)row * 1024 + cb + ct, v0, v1); ) }
    }
};
struct EpiPlain {
    static constexpr bool PERM = true, AFTER_DRAIN = false;
    bf16_t* O; int ldc; const float* RS; int mode;
    __device__ __forceinline__ void operator()(const f32x4 (&acc)[2][2][4][2], const Unit& u, int wr, int wc, int fr, int fq) const {
        if (mode == 0) { EPI_FOREACH( st8b(O + (size_t)row * ldc + u.pn * 256 + ct, v0, v1); ) }
        else if (mode == 1) { EPI_FOREACH( const float sc_ = __builtin_amdgcn_rsqf(RS[row] * (1.f / 256.f) + EPSN); st8b(O + (size_t)row * ldc + u.pn * 256 + ct, v0 * sc_, v1 * sc_); ) }
        else { EPI_FOREACH( const int c_ = u.pn * 256 + ct; f32x4 r0_ = *(const f32x4*)(RS + c_), r1_ = *(const f32x4*)(RS + c_ + 4);
                _Pragma("unroll") for (int j = 0; j < 4; ++j) { v0[j] *= __builtin_amdgcn_rsqf(r0_[j] * (1.f / 256.f) + EPSN); v1[j] *= __builtin_amdgcn_rsqf(r1_[j] * (1.f / 256.f) + EPSN); }
                st8b(O + (size_t)row * ldc + c_, v0, v1); ) }
    }
};
struct EpiQ {
    static constexpr bool PERM = true, AFTER_DRAIN = false;
    bf16_t* Qm; const float* TAB; const float* RSQ;
    __device__ __forceinline__ void operator()(const f32x4 (&acc)[2][2][4][2], const Unit& u, int wr, int wc, int fr, int fq) const {
        const bool samp = (u.pm == 64);
        if (u.pn < 2) { EPI_FOREACH( const float sc_ = C2M * __builtin_amdgcn_rsqf(RSQ[row] * (1.f / 384.f) + EPSN); v0 = v0 * sc_; v1 = v1 * sc_; st8b(Qm + (size_t)row * 768 + u.pn * 256 + ct, v0, v1); ) }
        else { EPI_FOREACH( const int pos = samp ? (PAST + (rt & 15)) : row; rope8(v0, v1, TAB + (size_t)pos * 32, fq); const float sc_ = C2M * __builtin_amdgcn_rsqf(RSQ[row] * (1.f / 384.f) + EPSN); v0 = v0 * sc_; v1 = v1 * sc_; st8b(Qm + (size_t)row * 768 + 512 + ct, v0, v1); ) }
    }
};
struct EpiGateA {
    static constexpr bool PERM = true, AFTER_DRAIN = false;
    const bf16_t* G; bf16_t* U;
    __device__ __forceinline__ void operator()(const f32x4 (&acc)[2][2][4][2], const Unit& u, int wr, int wc, int fr, int fq) const {
        EPI_FOREACH( const size_t o = (size_t)row * 1024 + u.pn * 256 + ct; f32x4 g0, g1; ld8b(G + o, g0, g1); st8b(U + o, v0 * g0, v1 * g1); )
    }
};
struct EpiGateB {
    static constexpr bool PERM = true, AFTER_DRAIN = false;
    const bf16_t* G; bf16_t* U;
    __device__ __forceinline__ void operator()(const f32x4 (&acc)[2][2][4][2], const Unit& u, int wr, int wc, int fr, int fq) const {
        EPI_FOREACH( const size_t o = (size_t)row * 1024 + u.pn * 256 + ct; f32x4 g0, g1; ld8b(G + o, g0, g1);
            f32x4 a0, a1; ld8b(U + o, a0, a1); st8b(U + o, a0 + v0 * g0, a1 + v1 * g1); )
    }
};
struct EpiOut {
    static constexpr bool PERM = true, AFTER_DRAIN = false;
    const float* xp; const float* xs; float* y; int layer;
    __device__ __forceinline__ void operator()(const f32x4 (&acc)[2][2][4][2], const Unit& u, int wr, int wc, int fr, int fq) const {
        const bool samp = (u.pm == 64);
        EPI_FOREACH( const size_t o = (size_t)row * 1024 + u.pn * 256 + ct;
            const float* r = (layer == 0) ? (samp ? xs + (size_t)rt * 1024 + u.pn * 256 + ct : xp + o) : (const float*)(y + o);
            const f32x4 r0 = *(const f32x4*)r, r1 = *(const f32x4*)(r + 4); st8f(y + o, r0 + v0, r1 + v1); )
    }
};

__device__ __forceinline__ int src_col(int mode, int n) {
    if (mode == 0) {
        if (n < 384) return n;
        if (n < 416) return 640 + (n - 384);
        if (n < 424) return 2720 + (n - 416);
        if (n < 512) return -1;
        if (n < 768) return 384 + (n - 512);
        if (n < 1280) return 672 + (n - 768);
        if (n < 1792) return 2728 + (n - 1280);
        if (n < 2304) return 1184 + (n - 1792);
        if (n < 2816) return 1696 + (n - 2304);
        if (n < 3328) return 2208 + (n - 2816);
        if (n < 4352) return 3240 + (n - 3328);
        return 4264 + (n - 4352);
    }
    if (mode == 1) { if (n < 512) return (n >> 6) * 96 + (n & 63); const int m = n - 512; return (m >> 5) * 96 + 64 + (m & 31); }
    if (mode == 2) return (n >> 6) * 128 + (n & 63);
    if (mode == 3) return (n >> 6) * 128 + 64 + (n & 63);
    return n;
}
__device__ __forceinline__ void tr_item(const float* W, int K, int Nsrc, int nblk, bf16_t* WT, int mode, LAS float* scr, int item, int lane) {
    const int kb = item / nblk, nb = item % nblk, k0 = 64 * kb, n0 = 32 * nb;
    const int sc = src_col(mode, n0 + (lane & 31));
#pragma unroll 32
    for (int i = 0; i < 32; ++i) { const int kk = 2 * i + (lane >> 5); scr[kk * 33 + (lane & 31)] = (sc >= 0) ? W[(size_t)(k0 + kk) * Nsrc + sc] : 0.f; }
    asm volatile("s_waitcnt lgkmcnt(0)" ::: "memory");
    const int c = lane & 7;
#pragma unroll
    for (int j = 0; j < 4; ++j) { const int n = (lane >> 3) + 8 * j; const LAS float* s = scr + (8 * c) * 33 + n;
        u32x4 o; o.x = pk2(s[0 * 33], s[1 * 33]); o.y = pk2(s[2 * 33], s[3 * 33]); o.z = pk2(s[4 * 33], s[5 * 33]); o.w = pk2(s[6 * 33], s[7 * 33]);
        *(u32x4*)(WT + (size_t)(n0 + n) * K + k0 + 8 * c) = o; }
    asm volatile("s_waitcnt lgkmcnt(0)" ::: "memory");
}
__device__ __forceinline__ void convert_weights(int l, LAS unsigned char* lds, int gw, int NGW, int wave, int lane) {
    LAS float* scr = (LAS float*)(lds + wave * 16384);
    unsigned char* wb = PWS_ + WS_W;
    const float* w_in = PIN_(8) + (size_t)l * DM * NINSRC; const float* w_uq = PIN_(10) + (size_t)l * 384 * 768; const float* w_ukv = PIN_(12) + (size_t)l * 256 * 1024;
    const float* w_oa = PIN_(14) + (size_t)l * 512 * 1024; const float* w_ob = PIN_(15) + (size_t)l * 512 * 1024; const float* w_out = PIN_(16) + (size_t)l * 1024 * 1024;
    constexpr int I_IN = 16 * (NIN / 32), I_UQ = 6 * 24, I_UK = 4 * 16, I_OA = 8 * 32, I_OUT = 16 * 32;
    constexpr int NITEMS = I_IN + I_UQ + 2 * I_UK + 2 * I_OA + I_OUT;
    for (int it = gw; it < NITEMS; it += NGW) {
        int r = it;
        if (r < I_IN) { tr_item(w_in, 1024, NINSRC, NIN / 32, (bf16_t*)(wb + W_IN), 0, scr, r, lane); continue; } r -= I_IN;
        if (r < I_UQ) { tr_item(w_uq, 384, 768, 24, (bf16_t*)(wb + W_UQ), 1, scr, r, lane); continue; } r -= I_UQ;
        if (r < I_UK) { tr_item(w_ukv, 256, 1024, 16, (bf16_t*)(wb + W_UK), 2, scr, r, lane); continue; } r -= I_UK;
        if (r < I_UK) { tr_item(w_ukv, 256, 1024, 16, (bf16_t*)(wb + W_UV), 3, scr, r, lane); continue; } r -= I_UK;
        if (r < I_OA) { tr_item(w_oa, 512, 1024, 32, (bf16_t*)(wb + W_OA), 4, scr, r, lane); continue; } r -= I_OA;
        if (r < I_OA) { tr_item(w_ob, 512, 1024, 32, (bf16_t*)(wb + W_OB), 4, scr, r, lane); continue; } r -= I_OA;
        tr_item(w_out, 1024, 1024, 32, (bf16_t*)(wb + W_OUT), 4, scr, r, lane);
    }
}
__device__ __forceinline__ void rms_row_1024(const float* xrow, const float* g, bf16_t* hout, float* fout, int lane) {
    const f32x4* xr = (const f32x4*)xrow + lane; const f32x4* gr = (const f32x4*)g + lane;
    f32x4 v[4]; float s = 0.f;
#pragma unroll
    for (int j = 0; j < 4; ++j) { v[j] = xr[64 * j]; s += (v[j].x * v[j].x + v[j].y * v[j].y) + (v[j].z * v[j].z + v[j].w * v[j].w); }
    const float inv = 1.0f / sqrtf(wave_sum(s) * (1.f / 1024.f) + EPSN);
#pragma unroll
    for (int j = 0; j < 4; ++j) { const f32x4 o = v[j] * inv * gr[64 * j];
        if (hout) { u32x2 w; w.x = pk2(o.x, o.y); w.y = pk2(o.z, o.w); *((u32x2*)hout + lane + 64 * j) = w; }
        else *((f32x4*)fout + lane + 64 * j) = o; }
}

__device__ __forceinline__ void rms_rows2_1024(const float* x1, const float* x2, const float* g, bf16_t* h1, bf16_t* h2, int lane) {
    const f32x4* a = (const f32x4*)x1 + lane; const f32x4* b = (const f32x4*)(x2 ? x2 : x1) + lane; const f32x4* gr = (const f32x4*)g + lane;
    f32x4 v[4], u[4]; float s1 = 0.f, s2 = 0.f;
#pragma unroll
    for (int j = 0; j < 4; ++j) { v[j] = a[64 * j]; u[j] = b[64 * j]; }
#pragma unroll
    for (int j = 0; j < 4; ++j) { s1 += (v[j].x * v[j].x + v[j].y * v[j].y) + (v[j].z * v[j].z + v[j].w * v[j].w); s2 += (u[j].x * u[j].x + u[j].y * u[j].y) + (u[j].z * u[j].z + u[j].w * u[j].w); }
#pragma unroll
    for (int o = 1; o < 64; o <<= 1) { s1 += __shfl_xor(s1, o); s2 += __shfl_xor(s2, o); }
    const float i1 = 1.0f / sqrtf(s1 * (1.f / 1024.f) + EPSN), i2 = 1.0f / sqrtf(s2 * (1.f / 1024.f) + EPSN);
#pragma unroll
    for (int j = 0; j < 4; ++j) { const f32x4 gg = gr[64 * j]; const f32x4 o1 = v[j] * i1 * gg, o2 = u[j] * i2 * gg;
        u32x2 w1; w1.x = pk2(o1.x, o1.y); w1.y = pk2(o1.z, o1.w); *((u32x2*)h1 + lane + 64 * j) = w1;
        if (h2) { u32x2 w2; w2.x = pk2(o2.x, o2.y); w2.y = pk2(o2.z, o2.w); *((u32x2*)h2 + lane + 64 * j) = w2; } }
}

__device__ __forceinline__ void rms_rows2_f32(float* x1, float* x2, const float* g, int lane) {
    f32x4* a = (f32x4*)x1 + lane; f32x4* b = (f32x4*)(x2 ? x2 : x1) + lane; const f32x4* gr = (const f32x4*)g + lane;
    f32x4 v[4], u[4]; float s1 = 0.f, s2 = 0.f;
#pragma unroll
    for (int j = 0; j < 4; ++j) { v[j] = a[64 * j]; u[j] = b[64 * j]; }
#pragma unroll
    for (int j = 0; j < 4; ++j) { s1 += (v[j].x * v[j].x + v[j].y * v[j].y) + (v[j].z * v[j].z + v[j].w * v[j].w); s2 += (u[j].x * u[j].x + u[j].y * u[j].y) + (u[j].z * u[j].z + u[j].w * u[j].w); }
#pragma unroll
    for (int o = 1; o < 64; o <<= 1) { s1 += __shfl_xor(s1, o); s2 += __shfl_xor(s2, o); }
    const float i1 = 1.0f / sqrtf(s1 * (1.f / 1024.f) + EPSN), i2 = 1.0f / sqrtf(s2 * (1.f / 1024.f) + EPSN);
#pragma unroll
    for (int j = 0; j < 4; ++j) { const f32x4 gg = gr[64 * j]; a[64 * j] = v[j] * i1 * gg; if (x2) b[64 * j] = u[j] * i2 * gg; }
}

__device__ __forceinline__ int crow(int r, int hi) { return (r & 3) + 8 * (r >> 2) + 4 * hi; }
struct AttnP { const bf16_t* Q; const bf16_t* K; const bf16_t* KR; const bf16_t* Vt; int vtp; const float* cum2; bf16_t* GO; const float* kmax; const bf16_t* GI; };
template <int DQK, bool FOX>
__device__ __forceinline__ void attn_unit_prompt(const AttnP& a, int h, int qb, LAS unsigned char* lds, int tid) {
    constexpr int ND = DQK / 16, KP = DQK * 2 + 16, VP = 144, KBYTES = 64 * KP, VBYTES = 64 * VP, BUF = KBYTES + VBYTES + 256;
    asm volatile("" : "+v"(tid));
    const int lane = tid & 63, r32 = lane & 31, hi = lane >> 5, w = __builtin_amdgcn_readfirstlane(tid >> 6);
    const int q = qb * 256 + w * 32 + r32;
    bf16x8 qr[ND];
    if (FOX) {
#pragma unroll
        for (int d0 = 0; d0 < ND; ++d0) qr[d0] = *(const bf16x8*)(a.Q + (size_t)q * 512 + h * 64 + d0 * 16 + hi * 8);
    } else {
#pragma unroll
        for (int d0 = 0; d0 < ND; ++d0) qr[d0] = (d0 < 4) ? *(const bf16x8*)(a.Q + (size_t)q * 768 + h * 64 + d0 * 16 + hi * 8)
                                                          : *(const bf16x8*)(a.Q + (size_t)q * 768 + 512 + h * 32 + (d0 - 4) * 16 + hi * 8);
    }
    float cq2 = 0.f; if (FOX) cq2 = a.cum2[(size_t)h * MP + q];
    const int NT = 4 * qb + 4, tmax = 4 * qb + (w >> 1);
    const int srow = tid >> 3, sch = tid & 7;
    const bf16_t* kg = a.K + (size_t)srow * 512 + h * 64 + sch * 8;
    const bf16_t* vg = a.Vt + (size_t)(h * 64 + srow) * a.vtp + sch * 8;
    const bf16_t* krg = FOX ? nullptr : a.KR + (size_t)(tid >> 2) * 32 + (tid & 3) * 8;
    const float* cg_ = FOX ? a.cum2 + (size_t)h * MP + (tid & 15) * 4 : nullptr;
    const unsigned kw = srow * KP + sch * 16, krw = (tid >> 2) * KP + 128 + (tid & 3) * 16;
    const unsigned vw0 = KBYTES + srow * VP + ((sch >> 1) * 16 + (sch & 1) * 4) * 2, vw1 = vw0 + 16;
    const unsigned cw = KBYTES + VBYTES + (tid & 15) * 16;
    u32x4 gk, gv, gkr = {0u, 0u, 0u, 0u}; f32x4 gc = {0.f, 0.f, 0.f, 0.f};
    { const int t0 = FOX ? NT - 1 : 0;
      gk = *(const u32x4*)(kg + (size_t)t0 * 64 * 512); gv = *(const u32x4*)(vg + t0 * 64);
      if (!FOX) { if (tid < 256) gkr = *(const u32x4*)(krg + (size_t)t0 * 64 * 32); } else { if (tid < 16) gc = *(const f32x4*)(cg_ + t0 * 64); } }
    float mrow = NEGB, lsum = 0.f; f32x16 o0 = {}, o1 = {};
    const unsigned kr0 = (unsigned)r32 * KP + hi * 16, vr0 = KBYTES + (unsigned)r32 * VP + hi * 16;
    float qkb = 0.f;
    if (FOX) { float ss = 0.f;
#pragma unroll
        for (int d0 = 0; d0 < ND; ++d0)
#pragma unroll
            for (int e = 0; e < 8; ++e) { const float v = bf2f((unsigned short)qr[d0][e]); ss += v * v; }
        ss += __shfl_xor(ss, 32);
        const f32x4 km = *(const f32x4*)(a.kmax + h * 256 + lane * 4);
        qkb = sqrtf(ss) * 1.002f * wave_max(fmaxf(fmaxf(km.x, km.y), fmaxf(km.z, km.w))) + cq2; }
    int done = 0;
    LAS int* flg = (LAS int*)(lds + 131072 + 512);
    for (int i = 0; i < NT; ++i) {
        const int t = FOX ? NT - 1 - i : i;
        LAS unsigned char* B = lds + (i & 1) * BUF;
        *(LAS u32x4*)(B + kw) = gk;
        *(LAS u32x2*)(B + vw0) = (u32x2){gv.x, gv.y}; *(LAS u32x2*)(B + vw1) = (u32x2){gv.z, gv.w};
        if (!FOX) { if (tid < 256) *(LAS u32x4*)(B + krw) = gkr; } else { if (tid < 16) *(LAS f32x4*)(B + cw) = gc; if (lane == 0) flg[(i & 1) * 8 + w] = done; }
        __syncthreads();
        if (FOX) { const LAS int* f = flg + (i & 1) * 8; if (f[0] & f[1] & f[2] & f[3] & f[4] & f[5] & f[6] & f[7]) break; }
        if (i + 1 < NT) { const int tn = FOX ? t - 1 : t + 1;
            gk = *(const u32x4*)(kg + (size_t)tn * 64 * 512); gv = *(const u32x4*)(vg + tn * 64);
            if (!FOX) { if (tid < 256) gkr = *(const u32x4*)(krg + (size_t)tn * 64 * 32); } else { if (tid < 16) gc = *(const f32x4*)(cg_ + tn * 64); }
        }
        if (t <= tmax && !done) {
            f32x16 p0, p1;
            if (FOX) {
#pragma unroll
                for (int g = 0; g < 4; ++g) { const f32x4 c0 = *(const LAS f32x4*)(B + KBYTES + VBYTES + (2 * g + hi) * 16), c1 = *(const LAS f32x4*)(B + KBYTES + VBYTES + 128 + (2 * g + hi) * 16);
#pragma unroll
                    for (int j = 0; j < 4; ++j) { p0[4 * g + j] = c0[j]; p1[4 * g + j] = c1[j]; } }
            } else { p0 = f32x16{}; p1 = f32x16{}; }
            bf16x8 kf[2 * ND], vf[8];
#pragma unroll
            for (int d0 = 0; d0 < ND; ++d0) { kf[2 * d0] = *(const LAS bf16x8*)(B + kr0 + d0 * 32); kf[2 * d0 + 1] = *(const LAS bf16x8*)(B + kr0 + 32 * KP + d0 * 32); }
            __builtin_amdgcn_sched_barrier(0);
            if (FOX) { p0 = cq2 - p0; p1 = cq2 - p1; }
            __builtin_amdgcn_s_setprio(1);
#pragma unroll
            for (int d0 = 0; d0 < ND; ++d0) {
                p0 = __builtin_amdgcn_mfma_f32_32x32x16_bf16(kf[2 * d0], qr[d0], p0, 0, 0, 0);
                p1 = __builtin_amdgcn_mfma_f32_32x32x16_bf16(kf[2 * d0 + 1], qr[d0], p1, 0, 0, 0);
            }
            __builtin_amdgcn_s_setprio(0);
#pragma unroll
            for (int s = 0; s < 4; ++s) { vf[2 * s] = *(const LAS bf16x8*)(B + vr0 + s * 32); vf[2 * s + 1] = *(const LAS bf16x8*)(B + vr0 + 32 * VP + s * 32); }
            __builtin_amdgcn_sched_barrier(0);
            if (FOX && t == tmax) { const int ql = q - 64 * t;
#pragma unroll
                for (int r = 0; r < 16; ++r) { const int kv = crow(r, hi); if (kv > ql) p0[r] = NEGB; if (kv + 32 > ql) p1[r] = NEGB; } }
            float mx = fmaxf(p0[0], p1[0]);
#pragma unroll
            for (int r = 1; r < 16; ++r) mx = fmaxf(mx, fmaxf(p0[r], p1[r]));
            mx = fmaxf(mx, __shfl_xor(mx, 32));
            const float mnew = fmaxf(mrow, mx);
            if (__any(mnew > mrow)) { const float alpha = __builtin_amdgcn_exp2f(mrow - mnew); mrow = mnew; lsum *= alpha; o0 = o0 * alpha; o1 = o1 * alpha; }
            p0 = p0 - mrow; p1 = p1 - mrow;
#pragma unroll
            for (int r = 0; r < 16; ++r) { p0[r] = __builtin_amdgcn_exp2f(p0[r]); p1[r] = __builtin_amdgcn_exp2f(p1[r]); }
            { const f32x16 ps = p0 + p1; lsum += ((ps[0] + ps[1]) + (ps[2] + ps[3])) + ((ps[4] + ps[5]) + (ps[6] + ps[7])) + (((ps[8] + ps[9]) + (ps[10] + ps[11])) + ((ps[12] + ps[13]) + (ps[14] + ps[15]))); }
            u32x4 pw[4];
#pragma unroll
            for (int s = 0; s < 2; ++s) {
                pw[s].x = pg8::cvt_pk_bf16(p0[8 * s + 0], p0[8 * s + 1]); pw[s].y = pg8::cvt_pk_bf16(p0[8 * s + 2], p0[8 * s + 3]); pw[s].z = pg8::cvt_pk_bf16(p0[8 * s + 4], p0[8 * s + 5]); pw[s].w = pg8::cvt_pk_bf16(p0[8 * s + 6], p0[8 * s + 7]);
                pw[2 + s].x = pg8::cvt_pk_bf16(p1[8 * s + 0], p1[8 * s + 1]); pw[2 + s].y = pg8::cvt_pk_bf16(p1[8 * s + 2], p1[8 * s + 3]); pw[2 + s].z = pg8::cvt_pk_bf16(p1[8 * s + 4], p1[8 * s + 5]); pw[2 + s].w = pg8::cvt_pk_bf16(p1[8 * s + 6], p1[8 * s + 7]);
            }
            __builtin_amdgcn_s_setprio(1);
#pragma unroll
            for (int s = 0; s < 4; ++s) {
                const bf16x8 pb = __builtin_bit_cast(bf16x8, pw[s]);
                o0 = __builtin_amdgcn_mfma_f32_32x32x16_bf16(vf[2 * s], pb, o0, 0, 0, 0);
                o1 = __builtin_amdgcn_mfma_f32_32x32x16_bf16(vf[2 * s + 1], pb, o1, 0, 0, 0);
            }
            __builtin_amdgcn_s_setprio(0);
            if (FOX && t > 0) { const float c2l = a.cum2[(size_t)h * MP + 64 * t - 1]; done = __all(qkb - c2l < mrow - 160.f) ? 1 : 0; }
        }
    }
    lsum += __shfl_xor(lsum, 32);
    const float inv = 1.0f / lsum;
    bf16_t* go = a.GO + (size_t)q * 512 + h * 64;
    const bf16_t* gi = a.GI + (size_t)q * 512 + h * 64;
#pragma unroll
    for (int db = 0; db < 2; ++db)
#pragma unroll
        for (int m = 0; m < 2; ++m) {
            const f32x16& o = db ? o1 : o0;
            f32x4 xa, xb;
#pragma unroll
            for (int jj = 0; jj < 4; ++jj) {
                const auto rr = __builtin_amdgcn_permlane32_swap(__float_as_uint(o[8 * m + jj] * inv), __float_as_uint(o[8 * m + 4 + jj] * inv), false, false);
                xa[jj] = __uint_as_float(rr[0]); xb[jj] = __uint_as_float(rr[1]); }
            const int dd = db * 32 + 16 * m + 8 * hi;
            f32x4 g0, g1; ld8b(gi + dd, g0, g1); st8b(go + dd, xa * g0, xb * g1);
        }
}

__device__ __forceinline__ void softmax_rows16(LAS float* S, int wave, int lane) {
#pragma unroll 1
    for (int rr = 0; rr < 2; ++rr) { LAS float* s = S + (2 * wave + rr) * TKEYS;
        float mx = NEGB; for (int j = lane; j < TKEYS; j += 64) mx = fmaxf(mx, s[j]);
        mx = wave_max(mx);
        float sum = 0.f; for (int j = lane; j < TKEYS; j += 64) { const float e = __builtin_amdgcn_exp2f(s[j] - mx); s[j] = e; sum += e; }
        sum = wave_sum(sum); const float inv = 1.0f / sum;
        for (int j = lane; j < TKEYS; j += 64) s[j] *= inv; }
}
__device__ __forceinline__ bf16x8 cvt8(const f32x4 a, const f32x4 b) { u32x4 w; w.x = pg8::cvt_pk_bf16(a[0], a[1]); w.y = pg8::cvt_pk_bf16(a[2], a[3]); w.z = pg8::cvt_pk_bf16(b[0], b[1]); w.w = pg8::cvt_pk_bf16(b[2], b[3]); return __builtin_bit_cast(bf16x8, w); }
__device__ __forceinline__ bf16x8 pfrag(const LAS float* S, int ks, int r32, int hi) { const LAS float* p = S + (r32 & 15) * TKEYS + ks * 16 + hi * 8; return cvt8(*(const LAS f32x4*)p, *(const LAS f32x4*)(p + 4)); }

__device__ __forceinline__ void sample_fox_unit(int l, int b, int h, LAS unsigned char* lds, int tid, bool dummy = false) {
    LAS float* S = (LAS float*)(lds + 4096); LAS float* Op = (LAS float*)(lds + 4096 + 66560);
    const int wave = __builtin_amdgcn_readfirstlane(tid >> 6), lane = tid & 63, r32 = lane & 31, hi = lane >> 5;
    const bf16_t* Qf = (const bf16_t*)(PWS_ + WS_A8 + A8_QF); bf16_t* GO = (bf16_t*)(PWS_ + WS_SB);
    const float* cum = (const float*)(PWS_ + WS_MISC + MI_CUMS) + (size_t)(b * 8 + h) * TKEYS;
    const float* ck = PIN_(4) + (size_t)l * 16 * PAST * 512 + (size_t)b * PAST * 512 + h * 64; const float* cv = PIN_(5) + (size_t)l * 16 * PAST * 512 + (size_t)b * PAST * 512 + h * 64;
    const float* nk = POUT_ + O_SFK + (size_t)l * MSM * 512 + (size_t)b * 16 * 512 + h * 64; const float* nv = POUT_ + O_SFV + (size_t)l * MSM * 512 + (size_t)b * 16 * 512 + h * 64;
    { bf16x8 qf[4];
#pragma unroll
      for (int d0 = 0; d0 < 4; ++d0) qf[d0] = *(const bf16x8*)(Qf + (size_t)(MP + b * 16 + (r32 & 15)) * 512 + h * 64 + d0 * 16 + hi * 8);
      const float cqv = cum[PAST + (r32 & 15)];
      for (int kb = wave; kb < 33; kb += 8) {
          const int j = kb * 32 + r32, jj = j < TKEYS ? j : TKEYS - 1; const float* kr = (jj < PAST) ? ck + (size_t)jj * 512 : nk + (size_t)(jj - PAST) * 512;
          f32x16 p = {};
#pragma unroll
          for (int d0 = 0; d0 < 4; ++d0) { const f32x4 a0 = *(const f32x4*)(kr + d0 * 16 + hi * 8), a1 = *(const f32x4*)(kr + d0 * 16 + hi * 8 + 4); p = __builtin_amdgcn_mfma_f32_32x32x16_bf16(cvt8(a0, a1), qf[d0], p, 0, 0, 0); }
          if (r32 < 16) {
#pragma unroll
              for (int g = 0; g < 4; ++g) { const int key = kb * 32 + 8 * g + 4 * hi; if (key < TKEYS) { const f32x4 cj = *(const f32x4*)(cum + key); f32x4 v;
#pragma unroll
                  for (int e = 0; e < 4; ++e) { v[e] = p[4 * g + e] + (cqv - cj[e]) * LOG2E; if (key + e > PAST + r32) v[e] = NEGB; }
                  *(LAS f32x4*)(S + r32 * TKEYS + key) = v; } }
          }
      } }
    __syncthreads();
    softmax_rows16(S, wave, lane);
    __syncthreads();
    { const int nb = wave & 1; f32x16 o = {};
#pragma unroll 9
      for (int ks = wave >> 1; ks < 65; ks += 4) { const float* vr = (ks < 64) ? cv + (size_t)(ks * 16 + hi * 8) * 512 : nv + (size_t)(hi * 8) * 512; f32x4 a0, a1;
#pragma unroll
          for (int e = 0; e < 4; ++e) { a0[e] = vr[(size_t)e * 512 + nb * 32 + r32]; a1[e] = vr[(size_t)(e + 4) * 512 + nb * 32 + r32]; }
          o = __builtin_amdgcn_mfma_f32_32x32x16_bf16(cvt8(a0, a1), pfrag(S, ks, r32, hi), o, 0, 0, 0); }
      if (r32 < 16) {
#pragma unroll
          for (int g = 0; g < 4; ++g) *(LAS f32x4*)(Op + ((wave >> 1) * 16 + r32) * 64 + nb * 32 + 8 * g + 4 * hi) = (f32x4){o[4 * g], o[4 * g + 1], o[4 * g + 2], o[4 * g + 3]};
      } }
    __syncthreads();
    for (int e = tid; e < 1024; e += 512) { const int t = e >> 6, d = e & 63; const float o = (Op[(0 * 16 + t) * 64 + d] + Op[(1 * 16 + t) * 64 + d]) + (Op[(2 * 16 + t) * 64 + d] + Op[(3 * 16 + t) * 64 + d]);
        bf16_t* g0 = GO + (size_t)(MP + b * 16 + t) * 512 + h * 64 + d; bf16_t* d0_ = dummy ? (bf16_t*)(PWS_ + WS_A1) + (g0 - GO) : g0; *d0_ = (bf16_t)f2bf(o * bf2f(*g0)); }
    __syncthreads();
}
__device__ __forceinline__ void sample_mla_unit(int l, int b, int h, LAS unsigned char* lds, int tid, bool dummy = false) {
    LAS float* Qn = (LAS float*)lds; LAS float* Qx = (LAS float*)(lds + 4096); LAS float* S = (LAS float*)(lds + 22528); LAS float* Ol = (LAS float*)(lds + 89088);
    const int wave = __builtin_amdgcn_readfirstlane(tid >> 6), lane = tid & 63, r32 = lane & 31, hi = lane >> 5;
    const bf16_t* Qm = (const bf16_t*)(PWS_ + WS_A2); bf16_t* GO = (bf16_t*)(PWS_ + WS_SA);
    const float* w_ukv = PIN_(12) + (size_t)l * 256 * 1024;
    const float* cc = PIN_(2) + (size_t)l * 16 * PAST * 256 + (size_t)b * PAST * 256; const float* ckr = PIN_(3) + (size_t)l * 16 * PAST * 32 + (size_t)b * PAST * 32;
    const float* nc = POUT_ + O_SCKV + (size_t)l * MSM * 256 + (size_t)b * 16 * 256; const float* nkr = POUT_ + O_SKR + (size_t)l * MSM * 32 + (size_t)b * 16 * 32;
    for (int e = tid; e < 1024; e += 512) { const int t = e >> 6, d = e & 63; Qn[e] = bf2f(Qm[(size_t)(MP + b * 16 + t) * 768 + h * 64 + d]); }
    { const int t = tid >> 5, i = tid & 31; Qx[t * 288 + 256 + i] = bf2f(Qm[(size_t)(MP + b * 16 + t) * 768 + 512 + h * 32 + i]); }
    __syncthreads();
    { const int c = tid & 255, tg = tid >> 8; const float* wr_ = w_ukv + (size_t)c * 1024 + h * 128; float acc8[8];
#pragma unroll
      for (int tt = 0; tt < 8; ++tt) acc8[tt] = 0.f;
#pragma unroll 16
      for (int d4 = 0; d4 < 16; ++d4) { const f32x4 w4 = *(const f32x4*)(wr_ + d4 * 4);
#pragma unroll
          for (int tt = 0; tt < 8; ++tt) { const f32x4 q4 = *(const LAS f32x4*)(Qn + (8 * tg + tt) * 64 + d4 * 4); acc8[tt] += (w4.x * q4.x + w4.y * q4.y) + (w4.z * q4.z + w4.w * q4.w); } }
#pragma unroll
      for (int tt = 0; tt < 8; ++tt) Qx[(8 * tg + tt) * 288 + c] = acc8[tt]; }
    __syncthreads();
    { bf16x8 qf[18];
#pragma unroll
      for (int d0 = 0; d0 < 18; ++d0) { const LAS float* p = Qx + (r32 & 15) * 288 + d0 * 16 + hi * 8; qf[d0] = cvt8(*(const LAS f32x4*)p, *(const LAS f32x4*)(p + 4)); }
      for (int kb = wave; kb < 33; kb += 8) {
          const int j = kb * 32 + r32, jj = j < TKEYS ? j : TKEYS - 1;
          const float* kc = (jj < PAST) ? cc + (size_t)jj * 256 : nc + (size_t)(jj - PAST) * 256; const float* kk = (jj < PAST) ? ckr + (size_t)jj * 32 : nkr + (size_t)(jj - PAST) * 32;
          f32x16 p = {};
#pragma unroll
          for (int d0 = 0; d0 < 18; ++d0) { const float* src = (d0 < 16) ? kc + d0 * 16 + hi * 8 : kk + (d0 - 16) * 16 + hi * 8;
              const f32x4 a0 = *(const f32x4*)src, a1 = *(const f32x4*)(src + 4); p = __builtin_amdgcn_mfma_f32_32x32x16_bf16(cvt8(a0, a1), qf[d0], p, 0, 0, 0); }
          if (r32 < 16) {
#pragma unroll
              for (int g = 0; g < 4; ++g) { const int key = kb * 32 + 8 * g + 4 * hi; if (key < TKEYS) *(LAS f32x4*)(S + r32 * TKEYS + key) = (f32x4){p[4 * g], p[4 * g + 1], p[4 * g + 2], p[4 * g + 3]}; }
          }
      } }
    __syncthreads();
    softmax_rows16(S, wave, lane);
    __syncthreads();
    { f32x16 o = {};
#pragma unroll 13
      for (int ks = 0; ks < 65; ++ks) { const float* vr = (ks < 64) ? cc + (size_t)(ks * 16 + hi * 8) * 256 : nc + (size_t)(hi * 8) * 256; f32x4 a0, a1;
#pragma unroll
          for (int e = 0; e < 4; ++e) { a0[e] = vr[(size_t)e * 256 + wave * 32 + r32]; a1[e] = vr[(size_t)(e + 4) * 256 + wave * 32 + r32]; }
          o = __builtin_amdgcn_mfma_f32_32x32x16_bf16(cvt8(a0, a1), pfrag(S, ks, r32, hi), o, 0, 0, 0); }
      if (r32 < 16) {
#pragma unroll
          for (int g = 0; g < 4; ++g) *(LAS f32x4*)(Ol + r32 * 256 + wave * 32 + 8 * g + 4 * hi) = (f32x4){o[4 * g], o[4 * g + 1], o[4 * g + 2], o[4 * g + 3]};
      } }
    __syncthreads();
    { const int d = tid & 63, cgp = tid >> 6; const float* wv = w_ukv + h * 128 + 64 + d + (size_t)(cgp * 32) * 1024; float acc[16];
#pragma unroll
      for (int t = 0; t < 16; ++t) acc[t] = 0.f;
#pragma unroll 8
      for (int c = 0; c < 32; ++c) { const float wv_ = wv[(size_t)c * 1024];
#pragma unroll
          for (int t = 0; t < 16; ++t) acc[t] += Ol[t * 256 + cgp * 32 + c] * wv_; }
#pragma unroll
      for (int t = 0; t < 16; ++t) S[(cgp * 16 + t) * 64 + d] = acc[t]; }
    __syncthreads();
    for (int e = tid; e < 1024; e += 512) { const int t = e >> 6, d = e & 63; float o = 0.f;
#pragma unroll
        for (int g = 0; g < 8; ++g) o += S[(g * 16 + t) * 64 + d];
        bf16_t* g0 = GO + (size_t)(MP + b * 16 + t) * 512 + h * 64 + d; bf16_t* d0_ = dummy ? (bf16_t*)(PWS_ + WS_A1) + (g0 - GO) : g0; *d0_ = (bf16_t)f2bf(o * bf2f(*g0)); }
    __syncthreads();
}

template <int NK>
__device__ __forceinline__ f32x16 mini_acc(const bf16_t* A, int lda, const bf16_t* Bt, int ldb, int wave, int r32, int hi) {
    const bf16_t* ap = A + (size_t)r32 * lda + hi * 8; const bf16_t* bp = Bt + (size_t)r32 * ldb + hi * 8;
    bf16x8 af[NK], bfr[NK];
#pragma unroll
    for (int s_ = 0; s_ < NK; ++s_) { const int ks = wave + 8 * s_; af[s_] = *(const bf16x8*)(ap + ks * 16); bfr[s_] = *(const bf16x8*)(bp + ks * 16); }
    f32x16 acc = {};
#pragma unroll
    for (int s_ = 0; s_ < NK; ++s_) acc = __builtin_amdgcn_mfma_f32_32x32x16_bf16(af[s_], bfr[s_], acc, 0, 0, 0);
    return acc;
}
__device__ __forceinline__ void mini_put(LAS float* Pp, const f32x16& acc, int wave, int r32, int hi) {
#pragma unroll
    for (int r = 0; r < 16; ++r) Pp[(wave * 32 + crow(r, hi)) * 32 + r32] = acc[r];
}
__device__ __forceinline__ float mini_sum(const LAS float* Pp, int i_, int j_) { float v = 0.f;
#pragma unroll
    for (int w2 = 0; w2 < 8; ++w2) v += Pp[(w2 * 32 + i_) * 32 + j_];
    return v; }

template <class Epi>
__device__ __forceinline__ void run_gemm(LAS unsigned char* lds, const bf16_t* A, const bf16_t* Bt, int M, int N, int K, int rot, const Epi& E) {
    int G = gridDim.x, bx = blockIdx.x, Kv = K; asm volatile("" : "+s"(Kv), "+s"(G), "+s"(bx));
    pg8::Gemm g{A, Bt, M, N, Kv}; pg8::StaticOrder S; S.init(M, N, G, (int)((bx + G - (rot % G)) % G));
    pg8::gemm_phase<Epi, pg8::StaticOrder, true, true>(lds, g, S, E);
}

typedef unsigned v4u_unused_;
#define XB_TMO      128
#define XB_XCNT(j)  (256  + 64 * (j))
#define XB_XSUB(j)  (1280 + 64 * (j))
#define XB_XGEN(j)  (2304 + 64 * (j))
#define XB_TOP      3328
#define XB_TOPGEN   3392
#define XCD_BAR_WORDS 3456
#define XB_SPIN_CAP (1u << 18)

__device__ __forceinline__ unsigned xb_ld(unsigned* p)              { return __hip_atomic_load(p, __ATOMIC_RELAXED, __HIP_MEMORY_SCOPE_AGENT); }
__device__ __forceinline__ unsigned xb_add(unsigned* p, unsigned v) { return __hip_atomic_fetch_add(p, v, __ATOMIC_RELAXED, __HIP_MEMORY_SCOPE_AGENT); }
__device__ __forceinline__ unsigned xb_xcc_id() { return (unsigned)__builtin_amdgcn_s_getreg((3 << 11) | 20) & 0xFu; }
#define XB_SPIN(cond, bar) do { unsigned _sp = 0; while (cond) { __builtin_amdgcn_s_sleep(1); \
    if ((++_sp & 255u) == 0u) { if (xb_ld(&(bar)[XB_TMO])) break; if (_sp > XB_SPIN_CAP) { atomicAdd(&(bar)[XB_TMO], 1u); break; } } } } while (0)

struct XcdBarrier {
    unsigned* bar; unsigned x;
    volatile LAS unsigned* st;
};

__device__ __forceinline__ XcdBarrier xcd_barrier_post(unsigned* bar, volatile LAS unsigned* st) {
    XcdBarrier b; b.bar = bar; b.x = xb_xcc_id(); b.st = st;
    if (threadIdx.x == 0) (void)xb_add(&bar[XB_XCNT(b.x)], 1u);
    return b;
}
__device__ __forceinline__ void xcd_barrier_complete(unsigned* bar, unsigned x, unsigned& nloc, unsigned& nx) {
    const unsigned G = gridDim.x * gridDim.y * gridDim.z;
    unsigned sum, cnt, mine, sp = 0u;
    for (;;) {
        sum = 0u; cnt = 0u; mine = 0u;
#pragma unroll
        for (unsigned j = 0; j < 16; ++j) { const unsigned c = xb_ld(&bar[XB_XCNT(j)]); sum += c; cnt += (c > 0u) ? 1u : 0u; mine = (j == x) ? c : mine; }
        if (sum == G) break;
        __builtin_amdgcn_s_sleep(1);
        if ((++sp & 255u) == 0u) { if (xb_ld(&bar[XB_TMO])) break; if (sp > XB_SPIN_CAP) { atomicAdd(&bar[XB_TMO], 1u); break; } }
    }
    nloc = mine > 0u ? mine : 1u; nx = cnt > 0u ? cnt : 1u;
}

__device__ __forceinline__ void xcd_barrier(const XcdBarrier& b) {
    asm volatile("s_waitcnt vmcnt(0)" ::: "memory");
    __syncthreads();
    if (threadIdx.x == 0) {
        unsigned* bar = b.bar;
        __builtin_amdgcn_s_waitcnt(0);
        unsigned nloc = b.st[0], nx = b.st[1];
        if (nloc == 0u) { xcd_barrier_complete(bar, b.x, nloc, nx); b.st[0] = nloc; b.st[1] = nx; }
        const unsigned old = xb_add(&bar[XB_XSUB(b.x)], 1u);
        const unsigned gen = old / nloc;
        if (old + 1u == (gen + 1u) * nloc) {
            __builtin_amdgcn_fence(__ATOMIC_RELEASE, "agent");
            asm volatile("s_waitcnt vmcnt(0)" ::: "memory");
            const unsigned og = xb_add(&bar[XB_TOP], 1u);
            const unsigned tg = og / nx;
            if (og + 1u == (tg + 1u) * nx) xb_add(&bar[XB_TOPGEN], 1u);
            else XB_SPIN(xb_ld(&bar[XB_TOPGEN]) == tg, bar);
            __builtin_amdgcn_fence(__ATOMIC_ACQUIRE, "agent");
            xb_add(&bar[XB_XGEN(b.x)], 1u);
            asm volatile("s_waitcnt vmcnt(0)" ::: "memory");
        } else {
            XB_SPIN(xb_ld(&bar[XB_XGEN(b.x)]) == gen, bar);
            __builtin_amdgcn_fence(__ATOMIC_ACQUIRE, "agent");
            asm volatile("s_waitcnt vmcnt(0)" ::: "memory");
        }
    }
    __syncthreads();
}

#define PH_LOCALS \
    LAS unsigned char* lds = lds0; asm volatile("" : "+s"(lds)); \
    int tid = threadIdx.x; asm volatile("" : "+v"(tid)); const int lane = tid & 63, wave = __builtin_amdgcn_readfirstlane(tid >> 6); (void)lane; \
    unsigned long long ws_i = (unsigned long long)PWS_, out_i = (unsigned long long)POUT_; asm volatile("" : "+s"(ws_i), "+s"(out_i)); \
    unsigned char* ws = (unsigned char*)(__attribute__((address_space(1))) unsigned char*)ws_i; float* out = (float*)(__attribute__((address_space(1))) float*)out_i; \
    int G = gridDim.x, bxl = blockIdx.x; asm volatile("" : "+s"(G), "+s"(bxl)); const int gw = bxl * 8 + wave, NGW = G * 8; (void)gw; (void)NGW; \
    bf16_t* H = (bf16_t*)(ws + WS_A1); bf16_t* U = H; bf16_t* CQ = (bf16_t*)(ws + WS_CQ); bf16_t* CKV = (bf16_t*)(ws + WS_A2 + 24 * MiB + 512 * 1024); \
    float* RSQ = (float*)(ws + WS_MISC + MI_RSQ); float* RSK = (float*)(ws + WS_MISC + MI_RSK); (void)RSQ; (void)RSK; \
    float* Zs = (float*)(ws + WS_A2); bf16_t* Qm = (bf16_t*)(ws + WS_A2); \
    bf16_t* SA = (bf16_t*)(ws + WS_SA); bf16_t* SB = (bf16_t*)(ws + WS_SB); bf16_t* GA = (bf16_t*)(ws + WS_GA); bf16_t* GB = (bf16_t*)(ws + WS_GB); \
    bf16_t* VTF = (bf16_t*)(ws + WS_VTF); \
    bf16_t* KR = (bf16_t*)(ws + WS_MISC + MI_KR); float* TAB = (float*)(ws + WS_MISC + MI_TAB); float* LOGF = (float*)(ws + WS_MISC + MI_LOGF); \
    float* CUM2 = (float*)(ws + WS_MISC + MI_CUM2); float* CUMS = (float*)(ws + WS_MISC + MI_CUMS); float* KMAX = (float*)(ws + WS_MISC + MI_KMAX); (void)KMAX; \
    bf16_t* Qf = (bf16_t*)(ws + WS_A8 + A8_QF); bf16_t* Kf = (bf16_t*)(ws + WS_A8 + A8_KF); bf16_t* Kn = (bf16_t*)(ws + WS_A8 + A8_KN); bf16_t* VTM = (bf16_t*)(ws + WS_A8 + A8_VTM); \
    float* Ua = (float*)(ws + WS_A8); \
    const bf16_t* Wt_in = (const bf16_t*)(ws + WS_W + W_IN); const bf16_t* Wt_uq = (const bf16_t*)(ws + WS_W + W_UQ); const bf16_t* Wt_uk = (const bf16_t*)(ws + WS_W + W_UK); \
    const bf16_t* Wt_uv = (const bf16_t*)(ws + WS_W + W_UV); const bf16_t* Wt_oa = (const bf16_t*)(ws + WS_W + W_OA); const bf16_t* Wt_ob = (const bf16_t*)(ws + WS_W + W_OB); \
    const bf16_t* Wt_out = (const bf16_t*)(ws + WS_W + W_OUT); \
    const float* xp = PIN_(0); const float* xs = PIN_(1); \
    (void)H; (void)U; (void)CQ; (void)CKV; (void)Zs; (void)Qm; (void)SA; (void)SB; (void)GA; (void)GB; (void)VTF; (void)KR; (void)TAB; (void)LOGF; (void)CUM2; (void)CUMS; (void)Qf; (void)Kf; (void)Kn; (void)VTM; (void)Ua; \
    (void)Wt_in; (void)Wt_uq; (void)Wt_uk; (void)Wt_uv; (void)Wt_oa; (void)Wt_ob; (void)Wt_out; (void)xp; (void)xs; (void)out; (void)G;
__global__ void __launch_bounds__(512, 2) mk_fwd(Params P) {
    extern __shared__ __attribute__((aligned(16))) unsigned char lds_raw[];
    LAS unsigned char* lds0 = (LAS unsigned char*)lds_raw;
    if (threadIdx.x == 0) { LAS unsigned long long* tb = (LAS unsigned long long*)(lds0 + 131072);
        tb[0] = (unsigned long long)P.in[0]; tb[1] = (unsigned long long)P.in[1]; tb[2] = (unsigned long long)P.in[2]; tb[3] = (unsigned long long)P.in[3]; tb[4] = (unsigned long long)P.in[4];
        tb[5] = (unsigned long long)P.in[5]; tb[6] = (unsigned long long)P.in[6]; tb[7] = (unsigned long long)P.in[7]; tb[8] = (unsigned long long)P.in[8]; tb[9] = (unsigned long long)P.in[9];
        tb[10] = (unsigned long long)P.in[10]; tb[11] = (unsigned long long)P.in[11]; tb[12] = (unsigned long long)P.in[12]; tb[13] = (unsigned long long)P.in[13]; tb[14] = (unsigned long long)P.in[14];
        tb[15] = (unsigned long long)P.in[15]; tb[16] = (unsigned long long)P.in[16]; tb[17] = (unsigned long long)P.in[17]; tb[18] = (unsigned long long)P.out; tb[19] = (unsigned long long)P.ws;
        ((LAS unsigned*)(lds0 + 131072 + 640))[0] = 0u; ((LAS unsigned*)(lds0 + 131072 + 640))[1] = 0u; }
    __syncthreads();
    cg::grid_group grid = cg::this_grid();
    const int lo = P.ph_lo, hi_ = P.ph_hi;
#define IN(k) (lo <= (k) && (k) < hi_)
    unsigned* barw = (unsigned*)(P.ws + WS_MISC + MI_BAR);
    XcdBarrier xbar = xcd_barrier_post(barw, (volatile LAS unsigned*)(lds0 + 131072 + 640));
    if (P.ph_lo < 0) grid.sync();
#define SEAM(k) do { if (IN(k) && IN((k) + 1)) xcd_barrier(xbar); } while (0)

    if (IN(0)) { PH_LOCALS

#ifndef T_SKIP_P0
        for (int e = bxl * 512 + tid; e < 2 * MT; e += G * 512) RSQ[e] = 0.f;
        convert_weights(0, lds, gw, NGW, wave, lane);
        for (int r = gw; r < MT; r += 2 * NGW) { const int r2 = r + NGW; const bool h2_ = r2 < MT;
            rms_rows2_1024(r < MP ? xp + (size_t)r * DM : xs + (size_t)(r - MP) * DM, h2_ ? (r2 < MP ? xp + (size_t)r2 * DM : xs + (size_t)(r2 - MP) * DM) : nullptr, PIN_(7), H + (size_t)r * DM, h2_ ? H + (size_t)r2 * DM : nullptr, lane); }
        for (int e = bxl * 512 + tid; e < MP * 16; e += G * 512) { const int pos = e >> 4, i = e & 15;
            const double inv = exp(-9.210340371976184 * (double)i / 16.0); const double rev = (double)pos * inv * 0.15915494309189535; const float fr_ = (float)(rev - rint(rev));
            TAB[(size_t)pos * 32 + i] = __builtin_amdgcn_cosf(fr_); TAB[(size_t)pos * 32 + 16 + i] = __builtin_amdgcn_sinf(fr_); }
#endif

    }
    SEAM(0);
#pragma unroll
    for (int l = 0; l < 2; ++l) {
        const int pb = 1 + 7 * l;
        if (IN(pb)) { PH_LOCALS

#ifndef T_SKIP_P1A
            EpiIn E{CQ, CKV, RSQ, RSK, PIN_(9) + l * 384, PIN_(11) + l * 256, SA, SB, Qf, Kf, GA, GB, KR, LOGF, TAB, PIN_(13) + l * 8, out, l};
            run_gemm(lds, H, Wt_in, MT, NIN, DM, 0, E);
#endif


#ifndef T_SKIP_P1B
            EpiPlain E2{VTF, MT, nullptr, 0};
            run_gemm(lds, Wt_in + (size_t)2816 * DM, H, 512, MT, DM, 88, E2);
#endif

        }
        SEAM(pb);
        if (IN(pb + 2)) { PH_LOCALS

#ifndef T_SKIP_P3
#ifndef T_SKIP_P3A
            EpiQ EQ{Qm, TAB, RSQ}; run_gemm(lds, CQ, Wt_uq, MT, 768, 384, 0, EQ);
#endif
#ifndef T_SKIP_P3B
            EpiPlain EK{Kn, 512, RSK, 1}; run_gemm(lds, CKV, Wt_uk, MP, 512, 256, 200, EK);
#endif
#ifndef T_SKIP_P3C
            EpiPlain EV{VTM, MT, RSK, 2}; run_gemm(lds, Wt_uv, CKV, 512, MP, 256, 328, EV);
#endif
#endif
            { const float* gkv = PIN_(11) + l * 256;
              const f32x4 g = *((const f32x4*)gkv + lane);
              for (int r = gw; r < MT; r += 4 * NGW) {
                  float* zr[4]; f32x4 v[4]; float rs[4];
#pragma unroll
                  for (int j = 0; j < 4; ++j) { const int rr = (r + j * NGW < MT) ? r + j * NGW : r;
                      zr[j] = (rr < MP) ? out + O_PCKV + (size_t)l * MP * 256 + (size_t)rr * 256 : out + O_SCKV + (size_t)l * MSM * 256 + (size_t)(rr - MP) * 256;
                      v[j] = *((const f32x4*)zr[j] + lane); rs[j] = RSK[rr]; }
#pragma unroll
                  for (int j = 0; j < 4; ++j) if (j == 0 || r + j * NGW < MT) *((f32x4*)zr[j] + lane) = v[j] * (1.0f / sqrtf(rs[j] * (1.f / 256.f) + EPSN)) * g; } }
            for (int job = gw; job < 2048; job += NGW) {
                const int hh = job >> 8, tt = job & 255; const bf16_t* kr_ = Kf + (size_t)(tt * 64 + lane) * 512 + hh * 64; float ss = 0.f;
#pragma unroll
                for (int c = 0; c < 8; ++c) { f32x4 a0, a1; ld8b(kr_ + c * 8, a0, a1); ss += (a0[0] * a0[0] + a0[1] * a0[1]) + (a0[2] * a0[2] + a0[3] * a0[3]) + (a1[0] * a1[0] + a1[1] * a1[1]) + (a1[2] * a1[2] + a1[3] * a1[3]); }
                const float nm = wave_max(sqrtf(ss) * 1.002f); if (lane == 0) KMAX[job] = nm; }
            for (int hh = bxl; hh < 8; hh += G) {
                LAS double* part = (LAS double*)lds; double loc = 0.0; float vals[32];
#pragma unroll
                for (int i = 0; i < 32; ++i) { vals[i] = LOGF[(size_t)(tid * 32 + i) * 8 + hh]; loc += (double)vals[i]; }
                double inc = loc;
#pragma unroll
                for (int o = 1; o < 64; o <<= 1) { const double t_ = __shfl_up(inc, o); if (lane >= o) inc += t_; }
                if (lane == 63) part[wave] = inc;
                __syncthreads();
                double pre = inc - loc; for (int w2 = 0; w2 < wave; ++w2) pre += part[w2];
#pragma unroll
                for (int i = 0; i < 32; ++i) { pre += (double)vals[i]; CUM2[(size_t)hh * MP + tid * 32 + i] = (float)(pre * 1.4426950408889634); }
                __syncthreads();
            }
            for (int jw = NGW - 1 - gw; jw < 128; jw += NGW) {
                const int b = jw >> 3, hh = jw & 7; const float* cl = PIN_(6) + (size_t)l * 16 * PAST * 8 + (size_t)b * PAST * 8 + hh;
                float vals[17]; double loc = 0.0;
#pragma unroll
                for (int i = 0; i < 17; ++i) { const int j = lane * 17 + i; float v = 0.f; if (j < PAST) v = cl[(size_t)j * 8]; else if (j < TKEYS) v = LOGF[(size_t)(MP + b * 16 + j - PAST) * 8 + hh]; vals[i] = v; loc += (double)v; }
                double inc = loc;
#pragma unroll
                for (int o = 1; o < 64; o <<= 1) { const double t_ = __shfl_up(inc, o); if (lane >= o) inc += t_; }
                double pre = inc - loc;
#pragma unroll
                for (int i = 0; i < 17; ++i) { const int j = lane * 17 + i; pre += (double)vals[i]; if (j < TKEYS) CUMS[(size_t)jw * TKEYS + j] = (float)pre; }
            }

        }
        SEAM(pb + 2);
        if (IN(pb + 3)) { PH_LOCALS
            const int vcu = (G % 8 == 0) ? (bxl % 8) * (G / 8) + bxl / 8 : bxl;
            for (int it = vcu; it < 256; it += G) {
                int tid2 = threadIdx.x; asm volatile("" : "+v"(tid2)); LAS unsigned char* lds2 = lds0; asm volatile("" : "+s"(lds2));
                { AttnP a{Qm, Kn, KR, VTM, MT, nullptr, SA, nullptr, SA}; const int hh = it >> 5, s = it & 31;
                  attn_unit_prompt<96, false>(a, hh, 63 - s, lds2, tid2); __syncthreads(); attn_unit_prompt<96, false>(a, hh, s, lds2, tid2); __syncthreads(); }
                if (it < 128) sample_mla_unit(l, it >> 3, it & 7, lds2, tid2); else sample_fox_unit(l, (it - 128) >> 3, it & 7, lds2, tid2);
            }
            { unsigned* qh = (unsigned*)(ws + WS_MISC + MI_QCNT) + 32 * l; LAS int* qs = (LAS int*)(lds0 + 131072 + 768);
              for (;;) {
                  int tid2 = threadIdx.x; asm volatile("" : "+v"(tid2)); LAS unsigned char* lds2 = lds0; asm volatile("" : "+s"(lds2));
                  if (tid2 == 0) qs[0] = (int)__hip_atomic_fetch_add(qh, 1u, __ATOMIC_RELAXED, __HIP_MEMORY_SCOPE_AGENT);
                  __syncthreads();
                  const int uq = qs[0];
                  __syncthreads();
                  if (uq >= 512) break;
                  AttnP a{Qf, Kf, nullptr, VTF, MT, CUM2, SB, KMAX, SB};
                  attn_unit_prompt<64, true>(a, uq & 7, 63 - (uq >> 3), lds2, tid2); __syncthreads();
              } }
        }
        SEAM(pb + 3);
        if (IN(pb + 4)) { PH_LOCALS

#ifndef T_SKIP_P5
            for (int blk = bxl; blk < 256; blk += G) {
                const int rb = blk >> 5, cb = blk & 31, row0 = MP + 32 * rb, col0 = 32 * cb, r32 = lane & 31, hi = lane >> 5;
                LAS float* PA = (LAS float*)lds; LAS float* PB = (LAS float*)(lds + 32768);
                const f32x16 accA = mini_acc<4>(SA + (size_t)row0 * 512, 512, Wt_oa + (size_t)col0 * 512, 512, wave, r32, hi);
                const f32x16 accB = mini_acc<4>(SB + (size_t)row0 * 512, 512, Wt_ob + (size_t)col0 * 512, 512, wave, r32, hi);
                mini_put(PA, accA, wave, r32, hi); mini_put(PB, accB, wave, r32, hi);
                __syncthreads();
                for (int e = tid; e < 1024; e += 512) { const int i_ = e >> 5, j_ = e & 31; const size_t idx = (size_t)(row0 + i_) * 1024 + col0 + j_;
                    U[idx] = (bf16_t)f2bf(bf2f(GA[idx]) * mini_sum(PA, i_, j_) + bf2f(GB[idx]) * mini_sum(PB, i_, j_)); }
                __syncthreads();
            }
            EpiGateA EA{GA, U}; run_gemm(lds, SA, Wt_oa, MP, DM, 512, 0, EA);
            EpiGateB EB{GB, U}; run_gemm(lds, SB, Wt_ob, MP, DM, 512, 0, EB);
#endif

        }
        SEAM(pb + 4);
        if (IN(pb + 5)) { PH_LOCALS
#ifndef T_SKIP_P6
for (int blk = bxl; blk < 256; blk += G) {
                const int rb = blk >> 5, cb = blk & 31, row0 = MP + 32 * rb, col0 = 32 * cb, r32 = lane & 31, hi = lane >> 5;
                LAS float* PA = (LAS float*)lds;
                const f32x16 accA = mini_acc<8>(U + (size_t)row0 * 1024, 1024, Wt_out + (size_t)col0 * 1024, 1024, wave, r32, hi);
                mini_put(PA, accA, wave, r32, hi);
                __syncthreads();
                for (int e = tid; e < 1024; e += 512) { const int i_ = e >> 5, j_ = e & 31; const size_t idx = (size_t)(row0 + i_) * 1024 + col0 + j_;
                    const float res = (l == 0) ? xs[(size_t)(row0 - MP + i_) * 1024 + col0 + j_] : out[O_Y + idx];
                    out[O_Y + idx] = res + mini_sum(PA, i_, j_); }
                __syncthreads();
            }
            EpiOut EO{xp, xs, out + O_Y, l}; run_gemm(lds, U, Wt_out, MP, DM, DM, 0, EO);
#endif
 }
        SEAM(pb + 5);
        if (IN(pb + 6)) { PH_LOCALS

#ifndef T_SKIP_P7
            if (l == 0) { convert_weights(1, lds, gw, NGW, wave, lane);
                for (int e = bxl * 512 + tid; e < 2 * MT; e += G * 512) RSQ[e] = 0.f;
                for (int r = gw; r < MT; r += 2 * NGW) { const int r2 = r + NGW; const bool h2_ = r2 < MT;
                    rms_rows2_1024(out + O_Y + (size_t)r * DM, h2_ ? out + O_Y + (size_t)r2 * DM : nullptr, PIN_(7) + DM, H + (size_t)r * DM, h2_ ? H + (size_t)r2 * DM : nullptr, lane); } }
            else { for (int r = gw; r < MT; r += 2 * NGW) { const int r2 = r + NGW; rms_rows2_f32(out + O_Y + (size_t)r * DM, r2 < MT ? out + O_Y + (size_t)r2 * DM : nullptr, PIN_(17), lane); } }
#endif

        }
        if (l == 0) SEAM(pb + 6);
    }
#undef IN
#undef SEAM
}

extern "C" void kernel_launch(void* const* d_in, const int* in_sizes, int n_in, void* d_out, int out_size, void* d_ws, size_t ws_size, hipStream_t stream) {
    static int grid = 0;
    if (grid == 0) {
        if (n_in != 18 || out_size != (int)O_TOTAL || ws_size < WS_END) { fprintf(stderr, "kernel_launch: unexpected shapes (n_in %d, out %d, ws %zu)\n", n_in, out_size, ws_size); grid = -1; return; }
        int dev = 0, cus = 0, per_cu = 0;
        hipGetDevice(&dev); hipDeviceGetAttribute(&cus, hipDeviceAttributeMultiprocessorCount, dev);
        hipFuncSetAttribute((const void*)mk_fwd, hipFuncAttributeMaxDynamicSharedMemorySize, LDS_BYTES);
        hipOccupancyMaxActiveBlocksPerMultiprocessor(&per_cu, (const void*)mk_fwd, 512, LDS_BYTES);
        (void)hipGetLastError();
        if (per_cu < 1) per_cu = 1;
        grid = cus * 1;
        if (grid <= 0) grid = 256;
    }
    if (grid < 0) return;
    Params p{};
    for (int i = 0; i < 18; ++i) p.in[i] = (const float*)d_in[i];
    p.out = (float*)d_out; p.ws = (unsigned char*)d_ws;
#if MK_MULTI
    for (int ph = 0; ph < 15; ++ph) { p.ph_lo = ph; p.ph_hi = ph + 1; hipLaunchKernelGGL(mk_fwd, dim3(grid), dim3(512), LDS_BYTES, stream, p); }
#else
    p.ph_lo = 0; p.ph_hi = 15;
    if (hipMemsetAsync((char*)d_ws + WS_MISC + MI_BAR, 0, 14336 + 256, stream) != hipSuccess) { fprintf(stderr, "kernel_launch: memset of the barrier words failed\n"); return; }
    void* args[] = {&p};
    hipError_t e = hipLaunchCooperativeKernel((const void*)mk_fwd, dim3(grid), dim3(512), args, LDS_BYTES, stream);
    if (e != hipSuccess) fprintf(stderr, "cooperative launch failed: %s (grid %d)\n", hipGetErrorString(e), grid);
#endif
}
```
